# Optimizing an MI355X kernel written in HIP

```python
import math
import jax, jax.numpy as jnp
from jax import lax
import numpy as np

D_MODEL = 1024
BATCH = 4
SEQ = 4096
DEPTH = 4

CHUNK = 64
Q_BLOCK = 128
ROPE_THETA = 500000.0
EPS = 1e-6
NEG_INF = -1e30
TINY = 1e-30
D_FF = 2816
MLA_HEADS = 4
MLA_NOPE = 128
MLA_ROPE = 64
MLA_V = 128
MLA_Q_RANK = 384
MLA_KV_RANK = 256
HG_HEADS = 4
HG_DK = 128
HG_DV = 128
DF_HEADS = 8
DF_DH = 64
DF_ROT = DF_DH // 4
N_EVEN = (DEPTH + 1) // 2
N_ODD = DEPTH // 2
EVEN_SPLITS = (MLA_Q_RANK, MLA_KV_RANK, MLA_ROPE, HG_HEADS * HG_DK, HG_HEADS * HG_DK, HG_HEADS * HG_DV, HG_HEADS * HG_DV)
EVEN_IN = sum(EVEN_SPLITS)
EVEN_MIX = MLA_HEADS * MLA_V + HG_HEADS * HG_DV
ODD_IN = 3 * DF_HEADS * 2 * DF_DH
ODD_MIX = DF_HEADS * 2 * DF_DH

kernel_name = 'hybrid_mla_hgrn2_diffattn_macaron'


def rms_norm(x, g):
    xf = x.astype(jnp.float32)
    y = xf * lax.rsqrt(jnp.mean(xf * xf, axis=-1, keepdims=True) + EPS)
    return (y * g.astype(jnp.float32)).astype(x.dtype)


def rope_tables(positions, dim):
    inv_freq = ROPE_THETA ** (-jnp.arange(0, dim, 2, dtype=jnp.float32) / dim)
    ang = positions.astype(jnp.float32)[..., None] * inv_freq
    return jnp.cos(ang), jnp.sin(ang)


def apply_rope(x, cos, sin):
    half = cos.shape[-1]
    shape = cos.shape[:2] + (1,) * (x.ndim - 3) + (half,)
    c = cos.reshape(shape)
    s = sin.reshape(shape)
    xf = x.astype(jnp.float32)
    x1, x2 = xf[..., :half], xf[..., half:]
    return jnp.concatenate([x1 * c - x2 * s, x2 * c + x1 * s], axis=-1).astype(x.dtype)


def partial_rope(x, cos, sin):
    rot = 2 * cos.shape[-1]
    return jnp.concatenate([apply_rope(x[..., :rot], cos, sin), x[..., rot:]], axis=-1)


def swiglu(x, w_gate, w_up, w_down):
    return (jax.nn.silu(x @ w_gate) * (x @ w_up)) @ w_down


def block_causal_mask(blk, seq):
    q_idx = blk * Q_BLOCK + jnp.arange(Q_BLOCK)
    k_idx = jnp.arange(seq)
    return (k_idx[None, :] // CHUNK) <= (q_idx[:, None] // CHUNK)


def to_query_blocks(t):
    b, s = t.shape[:2]
    return jnp.moveaxis(t.reshape((b, s // Q_BLOCK, Q_BLOCK) + t.shape[2:]), 1, 0)


def from_query_blocks(o):
    nb, b, qb = o.shape[:3]
    return jnp.moveaxis(o, 0, 1).reshape((b, nb * qb) + o.shape[3:])


def chunk_causal_attention(q, k, v, scale):
    seq = k.shape[1]

    def one_block(args):
        qb, blk = args
        s = jnp.einsum('bqhd,bkhd->bhqk', qb, k).astype(jnp.float32) * scale
        s = jnp.where(block_causal_mask(blk, seq), s, NEG_INF)
        p = jax.nn.softmax(s, axis=-1).astype(v.dtype)
        return jnp.einsum('bhqk,bkhd->bqhd', p, v)

    o = lax.map(one_block, (to_query_blocks(q), jnp.arange(seq // Q_BLOCK)))
    return from_query_blocks(o)


def chunk_causal_diff_attention(q, k, v, lam, scale):
    seq = k.shape[1]

    def one_block(args):
        qb, blk = args
        s = jnp.einsum('bqhcd,bkhcd->bchqk', qb, k).astype(jnp.float32) * scale
        s = jnp.where(block_causal_mask(blk, seq), s, NEG_INF)
        p = jax.nn.softmax(s, axis=-1)
        p = (p[:, 0] - lam * p[:, 1]).astype(v.dtype)
        return jnp.einsum('bhqk,bkhd->bqhd', p, v)

    o = lax.map(one_block, (to_query_blocks(q), jnp.arange(seq // Q_BLOCK)))
    return from_query_blocks(o)


def hgrn2_chunkwise(q, k, logf, v):
    b_, s_, h_, dk = q.shape
    dv = v.shape[-1]
    n = s_ // CHUNK

    def to_chunks(t):
        return jnp.moveaxis(t.reshape(b_, n, CHUNK, h_, t.shape[-1]), (1, 3), (0, 2))

    tril = jnp.tril(jnp.ones((CHUNK, CHUNK), dtype=bool))[:, :, None]

    def step(state, inp):
        qc, kc, gc, vc = inp
        bcum = jnp.cumsum(gc, axis=2)
        o_inter = jnp.einsum('bhtk,bhkv->bhtv', qc * jnp.exp(bcum), state)
        rel = bcum[:, :, :, None, :] - bcum[:, :, None, :, :]
        decay = jnp.where(tril, jnp.exp(jnp.where(tril, rel, 0.0)), 0.0)
        attn = jnp.einsum('bhtk,bhsk,bhtsk->bhts', qc, kc, decay)
        o_intra = jnp.einsum('bhts,bhsv->bhtv', attn, vc)
        b_last = bcum[:, :, -1:, :]
        k_dec = kc * jnp.exp(b_last - bcum)
        new_state = jnp.exp(b_last[:, :, 0, :])[..., None] * state + jnp.einsum('bhsk,bhsv->bhkv', k_dec, vc)
        return new_state, o_inter + o_intra

    init = jnp.zeros((b_, h_, dk, dv), jnp.float32)
    _, o = lax.scan(step, init, (to_chunks(q), to_chunks(k), to_chunks(logf), to_chunks(v)))
    return jnp.moveaxis(o, (0, 2), (1, 3)).reshape(b_, s_, h_, dv)


def even_mixer(h, cos_m, sin_m, w_in, g_q, w_uq, g_kv, w_ukv, lb, g_out, w_out):
    b_, s_, _ = h.shape
    z = h @ w_in
    idx = np.cumsum(EVEN_SPLITS)[:-1].tolist()
    c_q, c_kv, k_pe, hq, hf, hi, hg = jnp.split(z, idx, axis=-1)
    q = (rms_norm(c_q, g_q) @ w_uq).reshape(b_, s_, MLA_HEADS, MLA_NOPE + MLA_ROPE)
    q = jnp.concatenate([q[..., :MLA_NOPE], apply_rope(q[..., MLA_NOPE:], cos_m, sin_m)], axis=-1)
    kv = (rms_norm(c_kv, g_kv) @ w_ukv).reshape(b_, s_, MLA_HEADS, MLA_NOPE + MLA_V)
    k_nope, v = kv[..., :MLA_NOPE], kv[..., MLA_NOPE:]
    k_pe = apply_rope(k_pe.reshape(b_, s_, 1, MLA_ROPE), cos_m, sin_m)
    k = jnp.concatenate([k_nope, jnp.broadcast_to(k_pe, (b_, s_, MLA_HEADS, MLA_ROPE))], axis=-1)
    o_a = chunk_causal_attention(q, k, v, (MLA_NOPE + MLA_ROPE) ** -0.5)
    zf = hf.astype(jnp.float32).reshape(b_, s_, HG_HEADS, HG_DK)
    sig = jax.nn.sigmoid(zf)
    logf = jnp.log(jnp.maximum(lb + (1.0 - lb) * sig, TINY))
    kk = (1.0 - lb) * (1.0 - sig)
    qq = hq.astype(jnp.float32).reshape(b_, s_, HG_HEADS, HG_DK)
    vv = hi.astype(jnp.float32).reshape(b_, s_, HG_HEADS, HG_DV)
    o_b = hgrn2_chunkwise(qq, kk, logf, vv)
    gate = jax.nn.silu(hg.astype(jnp.float32).reshape(b_, s_, HG_HEADS, HG_DV))
    o_b = (rms_norm(o_b, g_out) * gate).astype(h.dtype)
    o = jnp.concatenate([o_a.reshape(b_, s_, -1), o_b.reshape(b_, s_, -1)], axis=-1)
    return o @ w_out


def odd_mixer(h, cos_d, sin_d, w_in, lam_p, g_head, w_out, lambda_init):
    b_, s_, _ = h.shape
    z = h @ w_in
    q, k, v = jnp.split(z, 3, axis=-1)
    q = partial_rope(q.reshape(b_, s_, DF_HEADS, 2, DF_DH), cos_d, sin_d)
    k = partial_rope(k.reshape(b_, s_, DF_HEADS, 2, DF_DH), cos_d, sin_d)
    v = v.reshape(b_, s_, DF_HEADS, 2 * DF_DH)
    lp = lam_p.astype(jnp.float32)
    lam = jnp.exp(jnp.sum(lp[0] * lp[1])) - jnp.exp(jnp.sum(lp[2] * lp[3])) + lambda_init
    o = chunk_causal_diff_attention(q, k, v, lam, DF_DH ** -0.5)
    o = rms_norm(o, g_head) * (1.0 - lambda_init)
    return o.reshape(b_, s_, -1) @ w_out


def setup_inputs(seed: int = 0) -> dict:
    key = jax.random.key(seed)
    ks = jax.random.split(key, 20)

    def nrm(k, shape, fan_in):
        return jax.random.normal(k, shape, jnp.float32) * fan_in ** -0.5

    def gain(k, shape):
        return 1.0 + 0.02 * jax.random.normal(k, shape, jnp.float32)

    x = jax.random.normal(ks[0], (BATCH, SEQ, D_MODEL), jnp.float32)
    offsets = jax.random.randint(ks[1], (BATCH, 1), 0, 64, dtype=jnp.int32) * CHUNK
    positions = (offsets + jnp.arange(SEQ, dtype=jnp.int32)[None, :]).astype(jnp.int32)
    return {
        'x': x,
        'positions': positions,
        'norm_g': gain(ks[2], (DEPTH, 3, 2, D_MODEL)),
        'ffn_w_gate': nrm(ks[3], (DEPTH, 2, D_MODEL, D_FF), D_MODEL),
        'ffn_w_up': nrm(ks[4], (DEPTH, 2, D_MODEL, D_FF), D_MODEL),
        'ffn_w_down': nrm(ks[5], (DEPTH, 2, D_FF, D_MODEL), D_FF),
        'ev_w_in': nrm(ks[6], (N_EVEN, D_MODEL, EVEN_IN), D_MODEL),
        'ev_g_q': gain(ks[7], (N_EVEN, MLA_Q_RANK)),
        'ev_w_uq': nrm(ks[8], (N_EVEN, MLA_Q_RANK, MLA_HEADS * (MLA_NOPE + MLA_ROPE)), MLA_Q_RANK),
        'ev_g_kv': gain(ks[9], (N_EVEN, MLA_KV_RANK)),
        'ev_w_ukv': nrm(ks[10], (N_EVEN, MLA_KV_RANK, MLA_HEADS * (MLA_NOPE + MLA_V)), MLA_KV_RANK),
        'ev_lb_logits': jax.random.normal(ks[11], (N_EVEN, HG_HEADS * HG_DK), jnp.float32),
        'ev_g_out': gain(ks[12], (N_EVEN, HG_HEADS, HG_DV)),
        'ev_w_out': nrm(ks[13], (N_EVEN, EVEN_MIX, D_MODEL), EVEN_MIX),
        'od_w_in': nrm(ks[14], (N_ODD, D_MODEL, ODD_IN), D_MODEL),
        'od_lambda': 0.1 * jax.random.normal(ks[15], (N_ODD, 4, DF_DH), jnp.float32),
        'od_g_head': gain(ks[16], (N_ODD, DF_HEADS, 2 * DF_DH)),
        'od_w_out': nrm(ks[17], (N_ODD, ODD_MIX, D_MODEL), ODD_MIX),
    }


def reference(x, positions, norm_g, ffn_w_gate, ffn_w_up, ffn_w_down, ev_w_in, ev_g_q, ev_w_uq, ev_g_kv, ev_w_ukv, ev_lb_logits, ev_g_out, ev_w_out, od_w_in, od_lambda, od_g_head, od_w_out):
    cos_m, sin_m = rope_tables(positions, MLA_ROPE)
    cos_d, sin_d = rope_tables(positions, DF_ROT)
    lb_w = jax.nn.softmax(ev_lb_logits.astype(jnp.float32), axis=0)
    lb_all = jnp.cumsum(lb_w, axis=0) - lb_w[0:1]
    for l in range(DEPTH):
        g = norm_g[l]
        h = swiglu(rms_norm(x, g[0, 0]), ffn_w_gate[l, 0], ffn_w_up[l, 0], ffn_w_down[l, 0])
        x = x + 0.5 * rms_norm(h, g[0, 1])
        h = rms_norm(x, g[1, 0])
        if l % 2 == 0:
            j = l // 2
            lb = lb_all[j].reshape(HG_HEADS, HG_DK)
            m = even_mixer(h, cos_m, sin_m, ev_w_in[j], ev_g_q[j], ev_w_uq[j], ev_g_kv[j], ev_w_ukv[j], lb, ev_g_out[j], ev_w_out[j])
        else:
            j = l // 2
            lambda_init = 0.8 - 0.6 * math.exp(-0.3 * l)
            m = odd_mixer(h, cos_d, sin_d, od_w_in[j], od_lambda[j], od_g_head[j], od_w_out[j], lambda_init)
        x = x + rms_norm(m, g[1, 1])
        h = swiglu(rms_norm(x, g[2, 0]), ffn_w_gate[l, 1], ffn_w_up[l, 1], ffn_w_down[l, 1])
        x = x + 0.5 * rms_norm(h, g[2, 1])
    return x
```

```cpp
#include <hip/hip_runtime.h>
#include <cstdio>
#include <cstdint>
#include <cmath>
namespace pg8 {
#define PG8_LAS __attribute__((address_space(3)))
typedef unsigned short bf16_t;
typedef short bf16x8 __attribute__((ext_vector_type(8)));
typedef float f32x4 __attribute__((ext_vector_type(4)));
typedef unsigned u32x4 __attribute__((ext_vector_type(4)));
constexpr int BM = 256, BK = 64, HALF = 128, HTB = HALF * BK * 2  , STAGE_BYTES = 8 * HTB, NXCD = 8, WGM = 8;

__host__ __device__ __forceinline__ int lds_byte(int r, int c) { const int st = (r >> 4) * 2 + (c >> 5), rr = r & 15, cc = c & 31, ob = rr * 64 + cc * 2; return st * 1024 + (ob ^ (((ob >> 9) & 1) << 5)); }
__host__ __device__ __forceinline__ void stage_rc(int b, int& R, int& C) { const int st = b / 1024, sb = b % 1024, swz = sb ^ (((sb >> 9) & 1) << 5); R = (st >> 1) * 16 + swz / 64; C = (st & 1) * 32 + (swz % 64) / 2; }
__host__ __device__ __forceinline__ int perm32(int rho) { const int n = rho >> 4, i = rho & 15; return 8 * (i >> 2) + 4 * n + (i & 3); }

struct Unit { int pm, pn; };
struct Gemm { const bf16_t* A; const bf16_t* Bt; int M, N, K, lda, ldb; };

struct StaticOrder {
    int nM, nN, nwg, G, c;
    __host__ __device__ void init(int M, int N, int G_, int c_) { nM = M / BM; nN = N / BM; nwg = nM * nN; G = G_; c = c_; }
    __host__ __device__ bool next(int i, Unit& u) const {
        const long L = (long)i * G + c; if (L >= nwg) return false;
        int wgid = (int)L; { const int q = nwg / NXCD, r = nwg % NXCD, xcd = wgid % NXCD, off = wgid / NXCD; wgid = (xcd < r ? xcd * (q + 1) : r * (q + 1) + (xcd - r) * q) + off; }
        const int nig = WGM * nN, gid = wgid / nig, fm = gid * WGM, gsz = (nM - fm) < WGM ? (nM - fm) : WGM;
        u.pm = fm + ((wgid % nig) % gsz); u.pn = (wgid % nig) / gsz; return true;
    }
    __device__ __forceinline__ void a_ready(const Unit&) const {}
    __device__ __forceinline__ void done(const Unit&) const {}
};

typedef float f32x2_t_ __attribute__((ext_vector_type(2))); typedef __bf16 bf16x2_t_ __attribute__((ext_vector_type(2)));
__device__ __forceinline__ unsigned cvt_pk_bf16(float lo, float hi) { f32x2_t_ v = {lo, hi}; bf16x2_t_ b = __builtin_convertvector(v, bf16x2_t_); return __builtin_bit_cast(unsigned, b); }
typedef float f32x2 __attribute__((ext_vector_type(2)));
__device__ __forceinline__ float fast_exp(float x) { return __builtin_amdgcn_exp2f(x * 1.4426950408889634f); }
__device__ __forceinline__ float silu_f(float g) { return g * __builtin_amdgcn_rcpf(1.f + __builtin_amdgcn_exp2f(-1.4426950408889634f * g)); }
__device__ __forceinline__ u32x4 pack8(const f32x4 a, const f32x4 b) { u32x4 w; w.x = cvt_pk_bf16(a[0], a[1]); w.y = cvt_pk_bf16(a[2], a[3]); w.z = cvt_pk_bf16(b[0], b[1]); w.w = cvt_pk_bf16(b[2], b[3]); return w; }

#define EPI_IDS int t_ = threadIdx.x; asm volatile("" : "+v"(t_)); const int wid_ = __builtin_amdgcn_readfirstlane(t_ >> 6), wr = wid_ >> 2, wc = wid_ & 3, fr = t_ & 15, fq = (t_ & 63) >> 4; (void)wr_; (void)wc_; (void)fr_; (void)fq_
struct EpiPlain {
    static constexpr bool PERM = true, AFTER_DRAIN = false;
    bf16_t* O; int ldc;
    __device__ __forceinline__ void operator()(const f32x4 (&acc)[2][2][4][2], const Unit& u, int wr_, int wc_, int fr_, int fq_) const {
        EPI_IDS;
        const int row0 = u.pm * BM + wr * 64 + fr, col0 = u.pn * BM + wc * 32 + 8 * fq;
#pragma unroll
        for (int ai = 0; ai < 2; ++ai)
#pragma unroll
            for (int m = 0; m < 4; ++m) { bf16_t* rowp = O + (size_t)(row0 + ai * HALF + m * 16) * ldc + col0;
#pragma unroll
                for (int bj = 0; bj < 2; ++bj) *(u32x4*)(rowp + bj * HALF) = pack8(acc[ai][bj][m][0], acc[ai][bj][m][1]); }
    }
};
struct EpiSwiglu {
    static constexpr bool PERM = true, AFTER_DRAIN = false;
    bf16_t* H; int ldh;
    __device__ __forceinline__ void operator()(const f32x4 (&acc)[2][2][4][2], const Unit& u, int wr_, int wc_, int fr_, int fq_) const {
        EPI_IDS;
        const int row0 = u.pm * BM + wr * 64 + fr, col0 = u.pn * HALF + wc * 32 + 8 * fq;
#pragma unroll
        for (int ai = 0; ai < 2; ++ai)
#pragma unroll
            for (int m = 0; m < 4; ++m) {
                f32x4 h0, h1;
#pragma unroll
                for (int i = 0; i < 4; ++i) { h0[i] = silu_f(acc[ai][0][m][0][i]) * acc[ai][1][m][0][i]; h1[i] = silu_f(acc[ai][0][m][1][i]) * acc[ai][1][m][1][i]; }
                *(u32x4*)(H + (size_t)(row0 + ai * HALF + m * 16) * ldh + col0) = pack8(h0, h1);
            }
    }
};
struct EpiZEven {
    static constexpr bool PERM = true, AFTER_DRAIN = false;
    bf16_t* Z; float* SP; bf16_t* Kb; const float* TM;
    __device__ __forceinline__ void operator()(const f32x4 (&acc)[2][2][4][2], const Unit& u, int wr_, int wc_, int fr_, int fq_) const {
        EPI_IDS;
        const int row0 = u.pm * BM + wr * 64 + fr, col0 = u.pn * BM + wc * 32 + 8 * fq;
#pragma unroll
        for (int ai = 0; ai < 2; ++ai)
#pragma unroll
            for (int m = 0; m < 4; ++m) {
                const int row = row0 + ai * HALF + m * 16;
#pragma unroll
                for (int bj = 0; bj < 2; ++bj) {
                    const f32x4 v0 = acc[ai][bj][m][0], v1 = acc[ai][bj][m][1];
                    *(u32x4*)(Z + (size_t)row * 2816 + col0 + bj * HALF) = pack8(v0, v1);
                    int slot = -1;
                    if (u.pn == 0) slot = bj * 4 + wc; else if (u.pn == 1) slot = (bj == 0 ? 8 : 12) + wc; else if (u.pn == 2 && bj == 0) slot = 16 + wc;
                    if (slot >= 0) {
                        float s = (v0[0] * v0[0] + v0[1] * v0[1]) + (v0[2] * v0[2] + v0[3] * v0[3]) + (v1[0] * v1[0] + v1[1] * v1[1]) + (v1[2] * v1[2] + v1[3] * v1[3]);
                        s += __shfl_xor(s, 16); s += __shfl_xor(s, 32);
                        if (fq == 0) SP[(size_t)row * 20 + slot] = s;
                    }
                    if (u.pn == 2 && bj == 1 && wc < 2) {
                        const int j = 4 * wc + fq;
                        const f32x4 c = *(const f32x4*)(TM + (size_t)row * 64 + 4 * j), s = *(const f32x4*)(TM + (size_t)row * 64 + 32 + 4 * j);
                        const f32x4 o1 = v0 * c - v1 * s, o2 = v1 * c + v0 * s;
                        const u32x4 w = pack8(o1, o2);
#pragma unroll
                        for (int h = 0; h < 4; ++h) *(u32x4*)(Kb + (size_t)row * 768 + h * 192 + 128 + 8 * j) = w;
                    }
                }
            }
    }
};
struct EpiQ {
    static constexpr bool PERM = true, AFTER_DRAIN = false;
    bf16_t* Q; const PG8_LAS float* RS; const PG8_LAS int* RSPM; const float* TM;
    __device__ __forceinline__ void operator()(const f32x4 (&acc)[2][2][4][2], const Unit& u, int wr_, int wc_, int fr_, int fq_) const {
        EPI_IDS;
        int slot = 0;
#pragma unroll
        for (int s = 1; s < 4; ++s) if (RSPM[s] == u.pm) slot = s;
        const int rl0 = wr * 64 + fr, row0 = u.pm * BM + rl0;
#pragma unroll
        for (int ai = 0; ai < 2; ++ai)
#pragma unroll
            for (int m = 0; m < 4; ++m) {
                const int row = row0 + ai * HALF + m * 16;
                const float rs = RS[slot * 256 + rl0 + ai * HALF + m * 16];
#pragma unroll
                for (int bj = 0; bj < 2; ++bj) {
                    const f32x4 v0 = acc[ai][bj][m][0] * rs, v1 = acc[ai][bj][m][1] * rs;
                    if (u.pn < 2) {
                        const int head = 2 * u.pn + bj;
                        *(u32x4*)(Q + (size_t)row * 768 + head * 192 + wc * 32 + 8 * fq) = pack8(v0, v1);
                    } else {
                        const int head = 2 * bj + (wc >> 1), j = 4 * (wc & 1) + fq;
                        const f32x4 cs = *(const f32x4*)(TM + (size_t)row * 64 + 4 * j), sn = *(const f32x4*)(TM + (size_t)row * 64 + 32 + 4 * j);
                        const f32x4 o1 = v0 * cs - v1 * sn, o2 = v1 * cs + v0 * sn;
                        *(u32x4*)(Q + (size_t)row * 768 + head * 192 + 128 + 8 * j) = pack8(o1, o2);
                    }
                }
            }
    }
};
struct EpiKV {
    static constexpr bool PERM = true, AFTER_DRAIN = false;
    bf16_t* Kb; bf16_t* Vb; const PG8_LAS float* RS; const PG8_LAS int* RSPM;
    __device__ __forceinline__ void operator()(const f32x4 (&acc)[2][2][4][2], const Unit& u, int wr_, int wc_, int fr_, int fq_) const {
        EPI_IDS;
        int slot = 0;
#pragma unroll
        for (int s = 1; s < 4; ++s) if (RSPM[s] == u.pm) slot = s;
        const int rl0 = wr * 64 + fr, row0 = u.pm * BM + rl0;
#pragma unroll
        for (int ai = 0; ai < 2; ++ai)
#pragma unroll
            for (int m = 0; m < 4; ++m) {
                const int row = row0 + ai * HALF + m * 16;
                const float rs = RS[slot * 256 + rl0 + ai * HALF + m * 16];
                *(u32x4*)(Kb + (size_t)row * 768 + u.pn * 192 + wc * 32 + 8 * fq) = pack8(acc[ai][0][m][0] * rs, acc[ai][0][m][1] * rs);
                *(u32x4*)(Vb + (size_t)row * 512 + u.pn * 128 + wc * 32 + 8 * fq) = pack8(acc[ai][1][m][0] * rs, acc[ai][1][m][1] * rs);
            }
    }
};
struct EpiZOdd {
    static constexpr bool PERM = true, AFTER_DRAIN = false;
    bf16_t* Z; const float* TD; float qscale;
    __device__ __forceinline__ void operator()(const f32x4 (&acc)[2][2][4][2], const Unit& u, int wr_, int wc_, int fr_, int fq_) const {
        EPI_IDS;
        const int row0 = u.pm * BM + wr * 64 + fr, col0 = u.pn * BM + wc * 32 + 8 * fq;
        const bool rot = (u.pn < 8) && ((wc & 1) == 0) && (fq < 2);
        const float sc = (u.pn < 4) ? qscale : 1.0f;
#pragma unroll
        for (int ai = 0; ai < 2; ++ai)
#pragma unroll
            for (int m = 0; m < 4; ++m) {
                const int row = row0 + ai * HALF + m * 16;
                f32x4 cs = {1.f, 1.f, 1.f, 1.f}, sn = {0.f, 0.f, 0.f, 0.f};
                if (rot) { cs = *(const f32x4*)(TD + (size_t)row * 16 + 4 * fq); sn = *(const f32x4*)(TD + (size_t)row * 16 + 8 + 4 * fq); }
#pragma unroll
                for (int bj = 0; bj < 2; ++bj) {
                    const f32x4 v0 = acc[ai][bj][m][0] * sc, v1 = acc[ai][bj][m][1] * sc;
                    const f32x4 o1 = rot ? (v0 * cs - v1 * sn) : v0, o2 = rot ? (v1 * cs + v0 * sn) : v1;
                    *(u32x4*)(Z + (size_t)row * 3072 + col0 + bj * HALF) = pack8(o1, o2);
                }
            }
    }
};

template <class Epi, class Sched, bool ALIGN_EPI = false, bool SP2 = false>
__device__ __forceinline__ void gemm_phase(PG8_LAS unsigned char* lds, const Gemm g, const Sched& S, const Epi& E) {
    int tid_ = threadIdx.x; asm volatile("" : "+v"(tid_)); const int tid = tid_, wid = __builtin_amdgcn_readfirstlane(tid >> 6), lane = tid & 63, wr = wid >> 2, wc = wid & 3, fr = lane & 15, fq = lane >> 4;
    int K_ = g.K; asm volatile("" : "+s"(K_)); const int K = K_, nt = K / BK;
    unsigned voffA[2], voffB[2];
#pragma unroll
    for (int i = 0; i < 2; ++i) { int R, C; stage_rc(tid * 16 + i * 8192, R, C); const int Rb = Epi::PERM ? ((R & ~31) + perm32(R & 31)) : R;
        voffA[i] = (unsigned)(R * g.lda + C) * 2u; voffB[i] = (unsigned)(Rb * g.ldb + C) * 2u; }
    const size_t kstep = (size_t)(BK * 2);
    const size_t hA = (size_t)HALF * g.lda * 2, hB = (size_t)HALF * g.ldb * 2;
    const size_t tA = 2 * hA, tB = 2 * hB;
    const unsigned ldsw = (unsigned)wid * 1024u;
    const int aoff = lds_byte(wr * 64 + fr, fq * 8), boff = lds_byte(wc * 32 + fr, fq * 8);
#define PG8_SA(b, h) (((b) * 2 + (h)) * HTB)
#define PG8_SB(b, h) ((4 + (b) * 2 + (h)) * HTB)
#define PG8_STAGE(bufoff, gbase, voff) do { _Pragma("unroll") for (int _i = 0; _i < 2; ++_i) \
        __builtin_amdgcn_global_load_lds((const unsigned*)((const char*)(gbase) + (voff)[_i]), (PG8_LAS unsigned*)(lds + (bufoff) + ldsw + _i * 8192), 16, 0, 0); } while (0)
#define PG8_LDA(dst, b, h) do { _Pragma("unroll") for (int m = 0; m < 4; ++m) _Pragma("unroll") for (int k = 0; k < 2; ++k) dst[m][k] = *(const PG8_LAS bf16x8*)(lds + PG8_SA(b, h) + aoff + m * 2048 + k * 1024); } while (0)
#define PG8_LDB(dst, b, h) do { _Pragma("unroll") for (int n = 0; n < 2; ++n) _Pragma("unroll") for (int k = 0; k < 2; ++k) dst[n][k] = *(const PG8_LAS bf16x8*)(lds + PG8_SB(b, h) + boff + n * 2048 + k * 1024); } while (0)
#define PG8_MMA(ai, bj, At, Bt) do { __builtin_amdgcn_s_setprio(1); _Pragma("unroll") for (int m = 0; m < 4; ++m) _Pragma("unroll") for (int n = 0; n < 2; ++n) _Pragma("unroll") for (int k = 0; k < 2; ++k) \
        acc[ai][bj][m][n] = __builtin_amdgcn_mfma_f32_16x16x32_bf16(Bt[n][k], At[m][k], acc[ai][bj][m][n], 0, 0, 0); __builtin_amdgcn_s_setprio(0); } while (0)
#define PG8_WAIT_V(n) asm volatile("s_waitcnt vmcnt(" #n ")" ::: "memory")
#define PG8_WAIT_L(n) asm volatile("s_waitcnt lgkmcnt(" #n ")" ::: "memory")
#define PG8_BAR __builtin_amdgcn_s_barrier()
#define PG8_SCHED __builtin_amdgcn_sched_barrier(0)
    Unit cur, nxt; int ui = 0;
    if (!S.next(0, cur)) return;
    f32x4 acc[2][2][4][2];
#pragma unroll
    for (int a = 0; a < 2; ++a)
#pragma unroll
        for (int b = 0; b < 2; ++b)
#pragma unroll
            for (int m = 0; m < 4; ++m)
#pragma unroll
                for (int n = 0; n < 2; ++n) acc[a][b][m][n] = (f32x4){0.f, 0.f, 0.f, 0.f};
    bf16x8 At[4][2], B0[2][2], B1[2][2];
    const char* cA = (const char*)g.A + (size_t)cur.pm * tA; const char* cB = (const char*)g.Bt + (size_t)cur.pn * tB;
    S.a_ready(cur);
    if constexpr (SP2) {
        PG8_STAGE(PG8_SB(0, 0), cB, voffB); PG8_STAGE(PG8_SB(0, 1), cB + hB, voffB); PG8_STAGE(PG8_SA(0, 0), cA, voffA); PG8_STAGE(PG8_SA(0, 1), cA + hA, voffA);
        if (wr == 1) PG8_BAR;
        PG8_WAIT_V(2); PG8_BAR;
        PG8_STAGE(PG8_SB(1, 0), cB + kstep, voffB); PG8_STAGE(PG8_SA(1, 0), cA + kstep, voffA); PG8_STAGE(PG8_SB(1, 1), cB + hB + kstep, voffB);
        PG8_WAIT_V(6); PG8_BAR;
    } else {
        PG8_STAGE(PG8_SB(0, 0), cB, voffB); PG8_STAGE(PG8_SA(0, 0), cA, voffA); PG8_STAGE(PG8_SB(0, 1), cB + hB, voffB); PG8_STAGE(PG8_SA(0, 1), cA + hA, voffA);
        if (wr == 1) PG8_BAR;
        PG8_WAIT_V(4); PG8_BAR;
        PG8_STAGE(PG8_SB(1, 0), cB + kstep, voffB); PG8_STAGE(PG8_SA(1, 0), cA + kstep, voffA); PG8_STAGE(PG8_SB(1, 1), cB + hB + kstep, voffB);
        PG8_WAIT_V(6); PG8_BAR;
    }
    for (;;) {
        const bool has_next = S.next(ui + 1, nxt);
        const char* nA = has_next ? (const char*)g.A + (size_t)nxt.pm * tA : cA; const char* nB = has_next ? (const char*)g.Bt + (size_t)nxt.pn * tB : cB;
#pragma unroll 1
        for (int t = 0; t < nt; t += 2) {
            const bool last = (t == nt - 2);
            const char* a1 = cA + (size_t)(t + 1) * kstep;
            const char* a2 = last ? nA : cA + (size_t)(t + 2) * kstep; const char* b2 = last ? nB : cB + (size_t)(t + 2) * kstep;
            const char* a3 = a2 + kstep; const char* b3 = b2 + kstep;
            if (last && has_next) S.a_ready(nxt);
            if constexpr (SP2) {
            PG8_LDB(B0, 0, 0); PG8_LDB(B1, 0, 1); PG8_SCHED; PG8_LDA(At, 0, 0); PG8_STAGE(PG8_SA(1, 1), a1 + hA, voffA);
            PG8_WAIT_V(8); PG8_WAIT_L(0); PG8_BAR; PG8_MMA(0, 0, At, B0); PG8_MMA(0, 1, At, B1); PG8_BAR; PG8_SCHED;
            PG8_LDA(At, 0, 1); PG8_STAGE(PG8_SB(0, 0), b2, voffB); PG8_STAGE(PG8_SB(0, 1), b2 + hB, voffB); PG8_STAGE(PG8_SA(0, 0), a2, voffA);
            PG8_WAIT_V(8); PG8_WAIT_L(0); PG8_BAR; PG8_MMA(1, 0, At, B0); PG8_MMA(1, 1, At, B1); PG8_BAR; PG8_SCHED;
            PG8_LDB(B0, 1, 0); PG8_LDB(B1, 1, 1); PG8_SCHED; PG8_LDA(At, 1, 0); PG8_STAGE(PG8_SA(0, 1), a2 + hA, voffA);
            PG8_WAIT_V(8); PG8_WAIT_L(0); PG8_BAR; PG8_MMA(0, 0, At, B0); PG8_MMA(0, 1, At, B1); PG8_BAR; PG8_SCHED;
            PG8_LDA(At, 1, 1); PG8_STAGE(PG8_SB(1, 0), b3, voffB); PG8_STAGE(PG8_SB(1, 1), b3 + hB, voffB); PG8_STAGE(PG8_SA(1, 0), a3, voffA);
            PG8_WAIT_V(8); PG8_WAIT_L(0); PG8_BAR; PG8_MMA(1, 0, At, B0); PG8_MMA(1, 1, At, B1); PG8_BAR; PG8_SCHED;
            } else {
            PG8_LDB(B0, 0, 0); PG8_SCHED; PG8_LDA(At, 0, 0); PG8_STAGE(PG8_SA(1, 1), a1 + hA, voffA);
            PG8_WAIT_L(8); PG8_BAR; PG8_WAIT_L(0); PG8_MMA(0, 0, At, B0); PG8_BAR; PG8_SCHED;
            PG8_LDB(B1, 0, 1); PG8_STAGE(PG8_SB(0, 0), b2, voffB);
            PG8_BAR; PG8_WAIT_L(0); PG8_MMA(0, 1, At, B1); PG8_BAR;
            PG8_LDA(At, 0, 1); PG8_STAGE(PG8_SA(0, 0), a2, voffA);
            PG8_BAR; PG8_WAIT_L(0); PG8_MMA(1, 0, At, B0); PG8_BAR; PG8_SCHED;
            PG8_STAGE(PG8_SB(0, 1), b2 + hB, voffB);
            PG8_WAIT_V(6); PG8_BAR; PG8_MMA(1, 1, At, B1); PG8_BAR;
            PG8_LDB(B0, 1, 0); PG8_SCHED; PG8_LDA(At, 1, 0); PG8_STAGE(PG8_SA(0, 1), a2 + hA, voffA);
            PG8_WAIT_L(8); PG8_BAR; PG8_WAIT_L(0); PG8_MMA(0, 0, At, B0); PG8_BAR; PG8_SCHED;
            PG8_LDB(B1, 1, 1); PG8_STAGE(PG8_SB(1, 0), b3, voffB);
            PG8_BAR; PG8_WAIT_L(0); PG8_MMA(0, 1, At, B1); PG8_BAR;
            PG8_LDA(At, 1, 1); PG8_STAGE(PG8_SA(1, 0), a3, voffA);
            PG8_BAR; PG8_WAIT_L(0); PG8_MMA(1, 0, At, B0); PG8_BAR; PG8_SCHED;
            PG8_STAGE(PG8_SB(1, 1), b3 + hB, voffB);
            PG8_WAIT_V(6); PG8_BAR; PG8_MMA(1, 1, At, B1); PG8_BAR;
            }
        }
        if constexpr (ALIGN_EPI) { if (wr == 0) PG8_BAR; }
        if constexpr (!Epi::AFTER_DRAIN) { E(acc, cur, wr, wc, fr, fq); S.done(cur); }
        if (!has_next) break;
#pragma unroll
        for (int a = 0; a < 2; ++a)
#pragma unroll
            for (int b = 0; b < 2; ++b)
#pragma unroll
                for (int m = 0; m < 4; ++m)
#pragma unroll
                    for (int n = 0; n < 2; ++n) acc[a][b][m][n] = (f32x4){0.f, 0.f, 0.f, 0.f};
        cur = nxt; cA = nA; cB = nB; ++ui;
        if constexpr (ALIGN_EPI) { if (wr == 1) PG8_BAR; }
    }
    PG8_WAIT_V(0);
    if constexpr (!ALIGN_EPI) { if (wr == 0) PG8_BAR; }
    PG8_BAR;
    if constexpr (Epi::AFTER_DRAIN) { E.fused(acc, cur, wr, wc, fr, fq, lds, wid, lane); S.done(cur); }
#undef PG8_SA
#undef PG8_SB
#undef PG8_STAGE
#undef PG8_LDA
#undef PG8_LDB
#undef PG8_MMA
#undef PG8_WAIT_V
#undef PG8_WAIT_L
#undef PG8_BAR
#undef PG8_SCHED
}
}

namespace att {
typedef unsigned short bf16_t;
using bf16x8 = __attribute__((ext_vector_type(8))) short;
using s16x4  = __attribute__((ext_vector_type(4))) short;
using f32x16 = __attribute__((ext_vector_type(16))) float;
using f32x4  = __attribute__((ext_vector_type(4))) float;
using u32x4  = __attribute__((ext_vector_type(4))) unsigned;
#define ADI __device__ __forceinline__
#define SBAR() __builtin_amdgcn_sched_barrier(0)
#define MFMA32(a, b, c) __builtin_amdgcn_mfma_f32_32x32x16_bf16((a), (b), (c), 0, 0, 0)
ADI int crow(int r, int hi) { return (r & 3) + 8 * (r >> 2) + 4 * hi; }
ADI unsigned cvtpk(float lo, float hi) { return pg8::cvt_pk_bf16(lo, hi); }
ADI float bf2f(unsigned short b) { return __uint_as_float((unsigned)b << 16); }
ADI float bflo(unsigned w) { return __uint_as_float(w << 16); }
ADI float bfhi(unsigned w) { return __uint_as_float(w & 0xffff0000u); }
ADI float fexp(float x) { return __builtin_amdgcn_exp2f(x * 1.4426950408889634f); }
template <int RB> ADI int kswz(int row, int colB) { return row * RB + (colB ^ ((row & 7) << 4)); }
ADI int v_st(int k, int c) { const int kk = (k & ~0xC) | ((k & 4) << 1) | ((k & 8) >> 1); return ((kk >> 3) * 4 + (c >> 5)) * 512 + ((kk & 7) * 32 + (c & 31)) * 2; }
ADI int v_rd_base(int lane) { return ((lane & 3) << 3) | (((lane >> 2) & 3) << 6) | (((lane >> 4) & 1) << 5) | (((lane >> 5) & 1) << 8); }
constexpr int v_rd_off(int d0, int ks, int half) { return d0 * 512 + ks * 4096 + half * 2048; }
template <int OFF> ADI s16x4 tr_read(int vb) { s16x4 r; asm volatile("ds_read_b64_tr_b16 %0, %1 offset:%2" : "=&v"(r) : "v"(vb), "i"(OFF) : "memory"); return r; }
#define PKLH(L, H) (bf16x8){L[0], L[1], L[2], L[3], H[0], H[1], H[2], H[3]}
template <int D0> ADI void vfrags(int vb, bf16x8& f0, bf16x8& f1, bf16x8& f2, bf16x8& f3) {
  const s16x4 l0 = tr_read<v_rd_off(D0, 0, 0)>(vb), h0 = tr_read<v_rd_off(D0, 0, 1)>(vb), l1 = tr_read<v_rd_off(D0, 1, 0)>(vb), h1 = tr_read<v_rd_off(D0, 1, 1)>(vb);
  const s16x4 l2 = tr_read<v_rd_off(D0, 2, 0)>(vb), h2 = tr_read<v_rd_off(D0, 2, 1)>(vb), l3 = tr_read<v_rd_off(D0, 3, 0)>(vb), h3 = tr_read<v_rd_off(D0, 3, 1)>(vb);
  asm volatile("s_waitcnt lgkmcnt(0)" ::: "memory"); SBAR();
  f0 = PKLH(l0, h0); f1 = PKLH(l1, h1); f2 = PKLH(l2, h2); f3 = PKLH(l3, h3);
}
template <int D0> ADI void pv_one(f32x16& od, int vb, bf16x8 pa0, bf16x8 pa1, bf16x8 pa2, bf16x8 pa3) {
  bf16x8 f0, f1, f2, f3; vfrags<D0>(vb, f0, f1, f2, f3);
  od = MFMA32(pa0, f0, od); od = MFMA32(pa1, f1, od); od = MFMA32(pa2, f2, od); od = MFMA32(pa3, f3, od);
}
#define PK4(P, BASE, OUT) do { unsigned a0_ = cvtpk(P[BASE + 0], P[BASE + 1]), a1_ = cvtpk(P[BASE + 2], P[BASE + 3]);   \
    unsigned b0_ = cvtpk(P[BASE + 4], P[BASE + 5]), b1_ = cvtpk(P[BASE + 6], P[BASE + 7]);                              \
    auto r0_ = __builtin_amdgcn_permlane32_swap(a0_, b0_, false, false); auto r1_ = __builtin_amdgcn_permlane32_swap(a1_, b1_, false, false); \
    u32x4 w_ = {r0_[0], r1_[0], r0_[1], r1_[1]}; OUT = *reinterpret_cast<bf16x8*>(&w_); } while (0)
ADI float half_swap_max(float v) { auto rr = __builtin_amdgcn_permlane32_swap(__float_as_uint(v), __float_as_uint(v), false, false); return fmaxf(__uint_as_float(rr[0]), __uint_as_float(rr[1])); }
ADI float half_swap_add(float v) { auto rr = __builtin_amdgcn_permlane32_swap(__float_as_uint(v), __float_as_uint(v), false, false); return __uint_as_float(rr[0]) + __uint_as_float(rr[1]); }

constexpr float THR2 = 11.5f;
template <int DQK>
ADI void attn_unit(const bf16_t* __restrict__ Qg, int ldq, const bf16_t* __restrict__ Kg, int ldk, const bf16_t* __restrict__ Vg, int ldv, bf16_t* __restrict__ Og, int ldo, int q0, char* lds) {
  constexpr int RB = DQK * 2, KTB = 64 * RB, ND0 = DQK / 16, NKP = DQK / 64, PPR = DQK / 8;
  int tid_ = threadIdx.x; asm volatile("" : "+v"(tid_));
  const int tid = tid_, wid = __builtin_amdgcn_readfirstlane(tid >> 6), lane = tid & 63, r32 = lane & 31, hi = lane >> 5;
  char* V_lds = lds; char* K_lds = lds + 32768;
  float* ws = (float*)(lds + 32768 + 2 * KTB) + wid * 64; float* li_l = ws; float* al_l = ws + 32;
  const int nt_unit = q0 / 64 + 4, nt_w = q0 / 64 + (wid >> 1) + 1;
  bf16x8 qr[ND0];
  { const bf16_t* Qw = Qg + (size_t)(q0 + wid * 32 + r32) * ldq + hi * 8;
#pragma unroll
    for (int d0 = 0; d0 < ND0; ++d0) qr[d0] = *reinterpret_cast<const bf16x8*>(Qw + d0 * 16); }
  const int sr = tid >> 4, sc = (tid & 15) * 8, vst0 = v_st(sr, sc), vst1 = v_st(32 + sr, sc);
  int krow[NKP], kcb[NKP];
#pragma unroll
  for (int i = 0; i < NKP; ++i) { const int idx = tid + 512 * i; krow[i] = idx / PPR; kcb[i] = (idx % PPR) * 16; }
  const int vb0 = (int)(uintptr_t)V_lds + v_rd_base(lane);
  bf16x8 vs0, vs1, ks[NKP];
#define ALOAD(k0) do { vs0 = *reinterpret_cast<const bf16x8*>(Vg + (size_t)((k0) + sr) * ldv + sc); vs1 = *reinterpret_cast<const bf16x8*>(Vg + (size_t)((k0) + 32 + sr) * ldv + sc); \
    _Pragma("unroll") for (int i_ = 0; i_ < NKP; ++i_) ks[i_] = *reinterpret_cast<const bf16x8*>(Kg + (size_t)((k0) + krow[i_]) * ldk + (kcb[i_] >> 1)); } while (0)
#define AWRITE(b) do { *(bf16x8*)(V_lds + (b) * 16384 + vst0) = vs0; *(bf16x8*)(V_lds + (b) * 16384 + vst1) = vs1; \
    _Pragma("unroll") for (int i_ = 0; i_ < NKP; ++i_) *(bf16x8*)(K_lds + (b) * KTB + kswz<RB>(krow[i_], kcb[i_])) = ks[i_]; } while (0)
  float m_reg = -1e30f, l_reg = 0.f; f32x16 o[4];
#pragma unroll
  for (int d = 0; d < 4; ++d)
#pragma unroll
    for (int r = 0; r < 16; ++r) o[d][r] = 0.f;
  ALOAD(0); AWRITE(0); __syncthreads();
  for (int j = 0; j < nt_unit; ++j) {
    const int buf = j & 1;
    if (j + 1 < nt_unit) ALOAD((j + 1) * 64);
    if (j < nt_w) {
      const char* Ks = K_lds + buf * KTB;
      f32x16 p0, p1;
#pragma unroll
      for (int r = 0; r < 16; ++r) { p0[r] = 0.f; p1[r] = 0.f; }
#pragma unroll
      for (int d0 = 0; d0 < ND0; ++d0) { const int cb = (d0 * 16 + hi * 8) * 2;
        const bf16x8 b0 = *reinterpret_cast<const bf16x8*>(Ks + kswz<RB>(r32, cb));
        const bf16x8 b1 = *reinterpret_cast<const bf16x8*>(Ks + kswz<RB>(32 + r32, cb));
        p0 = MFMA32(b0, qr[d0], p0); p1 = MFMA32(b1, qr[d0], p1);
        if ((d0 & 3) == 3) SBAR(); }
      float pmax = p0[0];
#pragma unroll
      for (int r = 1; r < 16; ++r) pmax = fmaxf(pmax, p0[r]);
#pragma unroll
      for (int r = 0; r < 16; ++r) pmax = fmaxf(pmax, p1[r]);
      pmax = half_swap_max(pmax);
      float mn, alpha;
      if (__all(pmax - m_reg <= THR2)) { mn = m_reg; alpha = 1.f; }
      else { mn = fmaxf(m_reg, pmax); alpha = __builtin_amdgcn_exp2f(m_reg - mn); m_reg = mn; }
      float ps = 0.f;
#pragma unroll
      for (int r = 0; r < 16; ++r) { p0[r] = __builtin_amdgcn_exp2f(p0[r] - mn); p1[r] = __builtin_amdgcn_exp2f(p1[r] - mn); ps += p0[r] + p1[r]; }
      ps = half_swap_add(ps);
      l_reg = l_reg * alpha + ps;
      bf16x8 pa0, pa1, pa2, pa3;
      PK4(p0, 0, pa0); PK4(p0, 8, pa1); PK4(p1, 0, pa2); PK4(p1, 8, pa3);
      if (__any(alpha < 1.f)) { if (hi == 0) al_l[r32] = alpha; asm volatile("s_waitcnt lgkmcnt(0)" ::: "memory");
#pragma unroll
        for (int r = 0; r < 16; ++r) { const float a = al_l[crow(r, hi)];
#pragma unroll
          for (int d = 0; d < 4; ++d) o[d][r] *= a; }
        asm volatile("s_waitcnt lgkmcnt(0)" ::: "memory"); }
      const int vb = vb0 + buf * 16384;
      pv_one<0>(o[0], vb, pa0, pa1, pa2, pa3); pv_one<1>(o[1], vb, pa0, pa1, pa2, pa3); pv_one<2>(o[2], vb, pa0, pa1, pa2, pa3); pv_one<3>(o[3], vb, pa0, pa1, pa2, pa3);
    }
    if (j + 1 < nt_unit) AWRITE(buf ^ 1);
    __syncthreads();
  }
  if (hi == 0) li_l[r32] = l_reg; asm volatile("s_waitcnt lgkmcnt(0)" ::: "memory");
  bf16_t* Ow = Og + (size_t)(q0 + wid * 32) * ldo;
#pragma unroll
  for (int r = 0; r < 16; ++r) { const int orow = crow(r, hi); const float rl = __builtin_amdgcn_rcpf(li_l[orow]);
#pragma unroll
    for (int d0 = 0; d0 < 4; ++d0) Ow[(size_t)orow * ldo + d0 * 32 + r32] = (bf16_t)(cvtpk(o[d0][r] * rl, 0.f) & 0xffffu); }
  asm volatile("s_waitcnt lgkmcnt(0)" ::: "memory");
#undef ALOAD
#undef AWRITE
}
}

#define GAS __attribute__((address_space(1)))
#define LAS __attribute__((address_space(3)))
typedef unsigned short bf16;
typedef unsigned v4u __attribute__((ext_vector_type(4)));
typedef float f32x4 __attribute__((ext_vector_type(4)));
typedef short bf16x8 __attribute__((ext_vector_type(8)));
typedef GAS unsigned gu32;
typedef GAS unsigned long long gu64;
#define RLX_AGENT __ATOMIC_RELAXED, __HIP_MEMORY_SCOPE_AGENT
#define LDS_WAIT() asm volatile("s_waitcnt lgkmcnt(0)" ::: "memory")
#define VM_WAIT() asm volatile("s_waitcnt vmcnt(0)" ::: "memory")
#define DI __device__ __forceinline__
DI unsigned f2bf(float f) { unsigned u = __builtin_bit_cast(unsigned, f); return (u + 0x7fffu + ((u >> 16) & 1u)) >> 16; }
DI unsigned pk2(float lo, float hi) { return f2bf(lo) | (f2bf(hi) << 16); }

constexpr int NWAVES = 8;
constexpr int M = 16384, D = 1024, FF = 2816, SEQ = 4096, NB = 4, DEPTH = 4;
constexpr int ZE = 2816, ZO = 3072;
constexpr float EPS = 1e-6f;
constexpr size_t MiB = 1u << 20;
constexpr size_t WS_CTL = 0, CTL_ZERO_BYTES = 1 * MiB;
constexpr size_t WS_LB = 1 * MiB;
constexpr size_t WS_TM = 2 * MiB;
constexpr size_t WS_TD = 6 * MiB;
constexpr size_t WS_W = 8 * MiB;
constexpr size_t W_GU0 = 0, W_D0 = 11534336, W_GU1 = 17301504, W_D1 = 28835840, W_MIX = 34603008;
constexpr size_t W_EIN = W_MIX, W_EUQ = W_MIX + 5767168, W_EUKV = W_EUQ + 589824, W_EOUT = W_EUKV + 524288;
constexpr size_t W_OIN = W_MIX, W_OOUT = W_MIX + 6291456;
constexpr size_t WS_XN = 50 * MiB;
constexpr size_t WS_Y = 82 * MiB;
constexpr size_t WS_Z = 114 * MiB;
constexpr size_t WS_Q = 210 * MiB, WS_K = 234 * MiB, WS_V = 258 * MiB;
constexpr size_t WS_UT = 274 * MiB;
constexpr size_t WS_OI = 306 * MiB;
constexpr size_t WS_QD = 338 * MiB;
constexpr size_t WS_DC = 354 * MiB;
constexpr size_t WS_SP = 355 * MiB;
constexpr size_t WS_END = 357 * MiB;
constexpr int CW_BAR = 4096;
constexpr int RING_OFF = 0, RING_BYTES = 131072;
constexpr int LDSCTL_OFF = RING_BYTES, MISC_OFF = LDSCTL_OFF + 320;
constexpr int LDS_BYTES = 147456;
constexpr int RS_OFF = 132096;

#define XB_TMO      128
#define XB_XCNT(j)  (256  + 64 * (j))
#define XB_XSUB(j)  (1280 + 64 * (j))
#define XB_XGEN(j)  (2304 + 64 * (j))
#define XB_TOP      3328
#define XB_TOPGEN   3392
#define XCD_BAR_WORDS 3456
#define XB_SPIN_CAP (1u << 21)

__device__ __forceinline__ unsigned xb_ld(unsigned* p)              { return __hip_atomic_load(p, __ATOMIC_RELAXED, __HIP_MEMORY_SCOPE_AGENT); }
__device__ __forceinline__ unsigned xb_add(unsigned* p, unsigned v) { return __hip_atomic_fetch_add(p, v, __ATOMIC_RELAXED, __HIP_MEMORY_SCOPE_AGENT); }
__device__ __forceinline__ unsigned xb_xcc_id() { return (unsigned)__builtin_amdgcn_s_getreg((3 << 11) | 20) & 0xFu; }
#define XB_SPIN(cond, bar) do { unsigned _sp = 0; while (cond) { __builtin_amdgcn_s_sleep(1); \
    if ((++_sp & 255u) == 0u) { if (xb_ld(&(bar)[XB_TMO])) break; if (_sp > XB_SPIN_CAP) { atomicAdd(&(bar)[XB_TMO], 1u); break; } } } } while (0)

struct XcdBarrier {
    unsigned* bar; unsigned x;
    volatile LAS unsigned* st;
};

__device__ __forceinline__ XcdBarrier xcd_barrier_post(unsigned* bar, volatile LAS unsigned* st) {
    XcdBarrier b; b.bar = bar; b.x = xb_xcc_id(); b.st = st;
    if (threadIdx.x == 0) (void)xb_add(&bar[XB_XCNT(b.x)], 1u);
    return b;
}
__device__ __forceinline__ void xcd_barrier_complete(unsigned* bar, unsigned x, unsigned& nloc, unsigned& nx) {
    const unsigned G = gridDim.x * gridDim.y * gridDim.z;
    unsigned sum, cnt, mine, sp = 0u;
    for (;;) {
        sum = 0u; cnt = 0u; mine = 0u;
#pragma unroll
        for (unsigned j = 0; j < 16; ++j) { const unsigned c = xb_ld(&bar[XB_XCNT(j)]); sum += c; cnt += (c > 0u) ? 1u : 0u; mine = (j == x) ? c : mine; }
        if (sum == G) break;
        __builtin_amdgcn_s_sleep(1);
        if ((++sp & 255u) == 0u) { if (xb_ld(&bar[XB_TMO])) break; if (sp > XB_SPIN_CAP) { atomicAdd(&bar[XB_TMO], 1u); break; } }
    }
    nloc = mine > 0u ? mine : 1u; nx = cnt > 0u ? cnt : 1u;
}

__device__ __forceinline__ void xcd_barrier(const XcdBarrier& b) {
    asm volatile("s_waitcnt vmcnt(0)" ::: "memory");
    __syncthreads();
    if (threadIdx.x == 0) {
        unsigned* bar = b.bar;
        __builtin_amdgcn_s_waitcnt(0);
        unsigned nloc = b.st[0], nx = b.st[1];
        if (nloc == 0u) { xcd_barrier_complete(bar, b.x, nloc, nx); b.st[0] = nloc; b.st[1] = nx; }
        const unsigned old = xb_add(&bar[XB_XSUB(b.x)], 1u);
        const unsigned gen = old / nloc;
        if (old + 1u == (gen + 1u) * nloc) {
            __builtin_amdgcn_fence(__ATOMIC_RELEASE, "agent");
            asm volatile("s_waitcnt vmcnt(0)" ::: "memory");
            const unsigned og = xb_add(&bar[XB_TOP], 1u);
            const unsigned tg = og / nx;
            if (og + 1u == (tg + 1u) * nx) xb_add(&bar[XB_TOPGEN], 1u);
            else XB_SPIN(xb_ld(&bar[XB_TOPGEN]) == tg, bar);
            __builtin_amdgcn_fence(__ATOMIC_ACQUIRE, "agent");
            xb_add(&bar[XB_XGEN(b.x)], 1u);
            asm volatile("s_waitcnt vmcnt(0)" ::: "memory");
        } else {
            XB_SPIN(xb_ld(&bar[XB_XGEN(b.x)]) == gen, bar);
            __builtin_amdgcn_fence(__ATOMIC_ACQUIRE, "agent");
            asm volatile("s_waitcnt vmcnt(0)" ::: "memory");
        }
    }
    __syncthreads();
}


struct Args { const void* in[18]; float* out; unsigned char* ws; float invf_m[32]; float invf_d[8]; float linit[2]; int ph_lo, ph_hi, li, pad; };
#define KA __attribute__((address_space(4)))
struct Frame {
    LAS unsigned char* lds; unsigned char* ldsg;
    volatile LAS unsigned* MISC;
    gu32* ctl;
    int tid, lane, wave, vcu, G, bx;
    unsigned char* ws;
};
DI float wave_sum(float v) {
#pragma unroll
    for (int o = 1; o < 64; o <<= 1) v += __shfl_xor(v, o);
    return v;
}
using att::bflo; using att::bfhi; using att::fexp; using att::bf2f;

enum { CV_GU = 0, CV_ID = 1, CV_EIN = 2, CV_EUQ = 3, CV_OIN = 4 };
DI void map_col(int kind, int n, int& col, int& which) {
    which = 0; col = n;
    if (kind == CV_GU) { const int pn = n >> 8, r = n & 255; which = (r < 128) ? 0 : 1; col = pn * 128 + (r & 127); }
    else if (kind == CV_EIN) {
        if (n < 640) col = n;
        else if (n < 704) { const int p = n - 640, j = p >> 3, nn = (p >> 2) & 1, i = p & 3; col = 640 + 32 * nn + 4 * j + i; }
        else if (n < 768) { which = -1; col = 0; }
        else col = n - 64;
    } else if (kind == CV_EUQ) {
        if (n < 512) { col = (n >> 7) * 192 + (n & 127); }
        else { const int r = n - 512, head = r >> 6, p = r & 63, j = p >> 3, nn = (p >> 2) & 1, i = p & 3; col = head * 192 + 128 + 32 * nn + 4 * j + i; }
    } else if (kind == CV_OIN) {
        if (n < 2048) { const int p = n & 63; if (p < 16) { const int j = p >> 3, nn = (p >> 2) & 1, i = p & 3; col = (n & ~63) + 8 * nn + 4 * j + i; } }
    }
}
DI void cvt_item(int kind, const float* a, const float* b, const float* scale, int ld, int K, int Ndst, bf16* WT, LAS float* scr, int item, int lane) {
    const int nblk = Ndst / 32, kb = item / nblk, nb = item % nblk, k0 = 64 * kb, n0 = 32 * nb;
    int col, which; map_col(kind, n0 + (lane & 31), col, which);
    const float* src = (which == 1) ? b : a;
#pragma unroll 8
    for (int i = 0; i < 32; ++i) { const int kk = 2 * i + (lane >> 5); float v = 0.f;
        if (which >= 0) { v = src[(size_t)(k0 + kk) * ld + col]; if (scale) v *= scale[k0 + kk]; }
        scr[kk * 33 + (lane & 31)] = v; }
    LDS_WAIT(); asm volatile("" ::: "memory");
    const int c = lane & 7;
#pragma unroll
    for (int j = 0; j < 4; ++j) { const int n = (lane >> 3) + 8 * j; const LAS float* s = scr + (8 * c) * 33 + n;
        v4u o; o.x = pk2(s[0 * 33], s[1 * 33]); o.y = pk2(s[2 * 33], s[3 * 33]); o.z = pk2(s[4 * 33], s[5 * 33]); o.w = pk2(s[6 * 33], s[7 * 33]);
        *(GAS v4u*)(WT + (size_t)(n0 + n) * K + k0 + 8 * c) = o; }
    LDS_WAIT(); asm volatile("" ::: "memory");
}
DI void convert_layer(Frame& F, KA const Args* A, int l) {
    LAS float* scr = (LAS float*)(F.lds + RING_OFF + F.wave * 16384);
    const int gw = F.vcu * NWAVES + F.wave, NGW = F.G * NWAVES;
    unsigned char* W = F.ws + WS_W;
    const float* wg = (const float*)A->in[3]; const float* wu = (const float*)A->in[4]; const float* wd = (const float*)A->in[5];
    constexpr int I_GU = 16 * 176, I_D = 44 * 32, I_EIN = 16 * 88, I_EUQ = 6 * 24, I_EUKV = 4 * 32, I_OUT = 16 * 32, I_OIN = 16 * 96;
    const bool even = (l & 1) == 0; const int j = l >> 1;
    const int nmix = even ? (I_EIN + I_EUQ + I_EUKV + I_OUT) : (I_OIN + I_OUT);
    const int total = 2 * (I_GU + I_D) + nmix;
    for (int it = gw; it < total; it += NGW) {
        int r = it;
        if (r < 2 * (I_GU + I_D)) {
            const int s = r / (I_GU + I_D); r -= s * (I_GU + I_D);
            const size_t wo = (size_t)(l * 2 + s) * 1024 * 2816;
            if (r < I_GU) cvt_item(CV_GU, wg + wo, wu + wo, nullptr, 2816, 1024, 5632, (bf16*)(W + (s ? W_GU1 : W_GU0)), scr, r, F.lane);
            else cvt_item(CV_ID, wd + wo, nullptr, nullptr, 1024, 2816, 1024, (bf16*)(W + (s ? W_D1 : W_D0)), scr, r - I_GU, F.lane);
            continue;
        }
        r -= 2 * (I_GU + I_D);
        if (even) {
            if (r < I_EIN) { cvt_item(CV_EIN, (const float*)A->in[6] + (size_t)j * 1024 * 2752, nullptr, nullptr, 2752, 1024, 2816, (bf16*)(W + W_EIN), scr, r, F.lane); continue; } r -= I_EIN;
            if (r < I_EUQ) { cvt_item(CV_EUQ, (const float*)A->in[8] + (size_t)j * 384 * 768, nullptr, (const float*)A->in[7] + j * 384, 768, 384, 768, (bf16*)(W + W_EUQ), scr, r, F.lane); continue; } r -= I_EUQ;
            if (r < I_EUKV) { cvt_item(CV_ID, (const float*)A->in[10] + (size_t)j * 256 * 1024, nullptr, (const float*)A->in[9] + j * 256, 1024, 256, 1024, (bf16*)(W + W_EUKV), scr, r, F.lane); continue; } r -= I_EUKV;
            cvt_item(CV_ID, (const float*)A->in[13] + (size_t)j * 1024 * 1024, nullptr, nullptr, 1024, 1024, 1024, (bf16*)(W + W_EOUT), scr, r, F.lane);
        } else {
            if (r < I_OIN) { cvt_item(CV_OIN, (const float*)A->in[14] + (size_t)j * 1024 * 3072, nullptr, nullptr, 3072, 1024, 3072, (bf16*)(W + W_OIN), scr, r, F.lane); continue; } r -= I_OIN;
            cvt_item(CV_ID, (const float*)A->in[17] + (size_t)j * 1024 * 1024, nullptr, nullptr, 1024, 1024, 1024, (bf16*)(W + W_OOUT), scr, r, F.lane);
        }
    }
}
constexpr int TR = 4;
DI void thin_rows(Frame& F, const float* xin, float* xout, const bf16* Y, const float* gpost, float c, const float* gpre, bf16* XN) {
    const int gw = F.vcu * NWAVES + F.wave, NGW = F.G * NWAVES;
    f32x4 gp[4], gq[4];
#pragma unroll
    for (int j = 0; j < 4; ++j) { gp[j] = Y ? *((const GAS f32x4*)gpost + F.lane + 64 * j) : (f32x4){0.f, 0.f, 0.f, 0.f}; gq[j] = gpre ? *((const GAS f32x4*)gpre + F.lane + 64 * j) : (f32x4){0.f, 0.f, 0.f, 0.f}; }
    for (int m0 = gw; m0 < M; m0 += TR * NGW) {
        f32x4 x[TR][4]; unsigned long long yw[TR][4];
#pragma unroll
        for (int r = 0; r < TR; ++r) { const int m = m0 + r * NGW; if (m < M) {
            const GAS f32x4* xr = (const GAS f32x4*)(xin + (size_t)m * D) + F.lane;
#pragma unroll
            for (int j = 0; j < 4; ++j) x[r][j] = __builtin_nontemporal_load(xr + 64 * j);
            if (Y) { const GAS unsigned long long* yr = (const GAS unsigned long long*)(Y + (size_t)m * D) + F.lane;
#pragma unroll
                for (int j = 0; j < 4; ++j) yw[r][j] = __builtin_nontemporal_load(yr + 64 * j); } } }
#pragma unroll
        for (int r = 0; r < TR; ++r) { const int m = m0 + r * NGW; if (m < M) {
            if (Y) {
                f32x4 y[4]; float ss = 0.f;
#pragma unroll
                for (int j = 0; j < 4; ++j) { const unsigned lo = (unsigned)yw[r][j], hi = (unsigned)(yw[r][j] >> 32);
                    y[j] = (f32x4){bflo(lo), bfhi(lo), bflo(hi), bfhi(hi)}; ss += (y[j].x * y[j].x + y[j].y * y[j].y) + (y[j].z * y[j].z + y[j].w * y[j].w); }
                const float rs = c / sqrtf(wave_sum(ss) * (1.f / D) + EPS);
                GAS f32x4* xo = (GAS f32x4*)(xout + (size_t)m * D) + F.lane;
#pragma unroll
                for (int j = 0; j < 4; ++j) { x[r][j] = x[r][j] + y[j] * gp[j] * rs; __builtin_nontemporal_store(x[r][j], xo + 64 * j); }
            }
            if (gpre) {
                float ss2 = 0.f;
#pragma unroll
                for (int j = 0; j < 4; ++j) ss2 += (x[r][j].x * x[r][j].x + x[r][j].y * x[r][j].y) + (x[r][j].z * x[r][j].z + x[r][j].w * x[r][j].w);
                const float rs2 = 1.f / sqrtf(wave_sum(ss2) * (1.f / D) + EPS);
                GAS unsigned long long* o8 = (GAS unsigned long long*)(XN + (size_t)m * D) + F.lane;
#pragma unroll
                for (int j = 0; j < 4; ++j) { const f32x4 v = x[r][j] * gq[j] * rs2;
                    __builtin_nontemporal_store((unsigned long long)pk2(v.x, v.y) | ((unsigned long long)pk2(v.z, v.w) << 32), o8 + 64 * j); }
            } } }
    }
}
DI void build_tables(Frame& F, KA const Args* A) {
    const int* pos = (const int*)A->in[1];
    float* TM = (float*)(F.ws + WS_TM); float* TD = (float*)(F.ws + WS_TD); float* LB = (float*)(F.ws + WS_LB);
    const int gt = F.vcu * 512 + F.tid, NT = F.G * 512;
    for (int idx = gt; idx < M * 40; idx += NT) {
        const int row = idx / 40, i = idx % 40;
        const float p = (float)pos[row];
        const float invf = (i < 32) ? A->invf_m[i] : A->invf_d[i - 32];
        const float ang = p * invf;
        const double rev = (double)ang * 0.15915494309189533577;
        const float fr = (float)(rev - __builtin_rint(rev));
        const float cs = __builtin_amdgcn_cosf(fr), sn = __builtin_amdgcn_sinf(fr);
        if (i < 32) { TM[(size_t)row * 64 + i] = cs; TM[(size_t)row * 64 + 32 + i] = sn; }
        else { TD[(size_t)row * 16 + (i - 32)] = cs; TD[(size_t)row * 16 + 8 + (i - 32)] = sn; }
    }
    const float* lg = (const float*)A->in[11];
    for (int i = gt; i < 512; i += NT) {
        const float l0 = lg[i], l1 = lg[512 + i], mx = fmaxf(l0, l1), e0 = fexp(l0 - mx), e1 = fexp(l1 - mx), w0 = e0 / (e0 + e1), w1 = e1 / (e0 + e1);
        LB[i] = w0 - w0; LB[512 + i] = (w0 + w1) - w0;
    }
}

DI void fill_rs(Frame& F, const pg8::StaticOrder& S, const float* SP, int off, int cnt4, float inv_n, float scale, LAS float* RS, LAS int* RSPM) {
    pg8::Unit u;
    if (F.tid < 4) RSPM[F.tid] = -1;
    __syncthreads();
    for (int i = 0; i < 4; ++i) { if (!S.next(i, u)) break;
        if (F.tid == 0) RSPM[i] = u.pm;
        if (F.tid < 256) { const float* p = SP + (size_t)(u.pm * 256 + F.tid) * 20 + off; float ss = 0.f;
            for (int c = 0; c < cnt4; ++c) { const f32x4 a = *(const f32x4*)(p + 4 * c); ss += (a[0] + a[1]) + (a[2] + a[3]); }
            RS[i * 256 + F.tid] = scale / sqrtf(ss * inv_n + EPS); } }
    __syncthreads();
}
DI void hgrn_h1_unit(Frame& F, int unit, int j) {
    using namespace att;
    const bf16* Z = (const bf16*)(F.ws + WS_Z); const float* LBt = (const float*)(F.ws + WS_LB) + j * 512;
    bf16* QD = (bf16*)(F.ws + WS_QD); float* OI = (float*)(F.ws + WS_OI); bf16* UT = (bf16*)(F.ws + WS_UT); float* DC = (float*)(F.ws + WS_DC);
    const int bh = unit >> 6, c = unit & 63, b = bh >> 2, h = bh & 3, row0 = b * SEQ + c * 64;
    unsigned char* lds = F.ldsg;
    constexpr int LP = 132;
    float* L = (float*)lds; float* SEG = (float*)(lds + 33792);
    char* QM = (char*)lds + 36864; char* KM = (char*)lds + 53248; char* KT = (char*)lds + 69632; char* VI = (char*)lds + 86016;
    const int tid = F.tid, wid = F.wave, lane = F.lane, r32 = lane & 31, hi = lane >> 5;
    const int sr = tid >> 4, sc = (tid & 15) * 8;
    float kk[2][8];
#pragma unroll
    for (int e = 0; e < 2; ++e) { const int rr = sr + 32 * e;
        const v4u zf = *(const v4u*)(Z + (size_t)(row0 + rr) * ZE + 1280 + h * 128 + sc);
        const f32x4 lb0 = *(const f32x4*)(LBt + h * 128 + sc), lb1 = *(const f32x4*)(LBt + h * 128 + sc + 4);
        float zv[8] = {bflo(zf.x), bfhi(zf.x), bflo(zf.y), bfhi(zf.y), bflo(zf.z), bfhi(zf.z), bflo(zf.w), bfhi(zf.w)};
        float lf[8];
#pragma unroll
        for (int i = 0; i < 8; ++i) { const float lb = (i < 4) ? lb0[i & 3] : lb1[i & 3];
            const float sig = __builtin_amdgcn_rcpf(1.f + fexp(-zv[i]));
            const float f = lb + (1.f - lb) * sig;
            lf[i] = __builtin_amdgcn_logf(fmaxf(f, 1e-30f)) * 0.69314718055994531f;
            kk[e][i] = (1.f - lb) * (1.f - sig); }
        *(f32x4*)(L + rr * LP + sc) = (f32x4){lf[0], lf[1], lf[2], lf[3]}; *(f32x4*)(L + rr * LP + sc + 4) = (f32x4){lf[4], lf[5], lf[6], lf[7]};
    }
    __syncthreads();
    { const int col = tid & 127, seg = tid >> 7; float run = 0.f;
#pragma unroll
      for (int i = 0; i < 16; ++i) { run += L[(16 * seg + i) * LP + col]; L[(16 * seg + i) * LP + col] = run; }
      SEG[seg * 128 + col] = run;
      __syncthreads();
      float off = 0.f;
#pragma unroll
      for (int s = 0; s < 3; ++s) off += (s < seg) ? SEG[s * 128 + col] : 0.f;
#pragma unroll
      for (int i = 0; i < 16; ++i) L[(16 * seg + i) * LP + col] += off;
    }
    __syncthreads();
#pragma unroll
    for (int e = 0; e < 2; ++e) { const int rr = sr + 32 * e;
        const v4u zq = *(const v4u*)(Z + (size_t)(row0 + rr) * ZE + 768 + h * 128 + sc);
        const v4u zi = *(const v4u*)(Z + (size_t)(row0 + rr) * ZE + 1792 + h * 128 + sc);
        float q[8] = {bflo(zq.x), bfhi(zq.x), bflo(zq.y), bfhi(zq.y), bflo(zq.z), bfhi(zq.z), bflo(zq.w), bfhi(zq.w)};
        float qm[8], km[8], kt[8], qd[8];
#pragma unroll
        for (int i = 0; i < 8; ++i) { const float bc = L[rr * LP + sc + i], bl = L[63 * LP + sc + i], rf = L[31 * LP + sc + i];
            qm[i] = q[i] * fexp(bc - rf); km[i] = kk[e][i] * fexp(rf - bc); kt[i] = kk[e][i] * fexp(bl - bc); qd[i] = q[i] * fexp(bc); }
        *(v4u*)(QM + kswz<256>(rr, sc * 2)) = (v4u){cvtpk(qm[0], qm[1]), cvtpk(qm[2], qm[3]), cvtpk(qm[4], qm[5]), cvtpk(qm[6], qm[7])};
        *(v4u*)(KM + kswz<256>(rr, sc * 2)) = (v4u){cvtpk(km[0], km[1]), cvtpk(km[2], km[3]), cvtpk(km[4], km[5]), cvtpk(km[6], km[7])};
        *(v4u*)(KT + v_st(rr, sc)) = (v4u){cvtpk(kt[0], kt[1]), cvtpk(kt[2], kt[3]), cvtpk(kt[4], kt[5]), cvtpk(kt[6], kt[7])};
        *(v4u*)(VI + v_st(rr, sc)) = zi;
        *(v4u*)(QD + (size_t)(row0 + rr) * 512 + h * 128 + sc) = (v4u){cvtpk(qd[0], qd[1]), cvtpk(qd[2], qd[3]), cvtpk(qd[4], qd[5]), cvtpk(qd[6], qd[7])};
    }
    if (tid < 128) DC[(size_t)unit * 128 + tid] = fexp(L[63 * LP + tid]);
    __syncthreads();
    const int tb = wid & 1, vb = wid >> 1;
    f32x16 p0, p1;
#pragma unroll
    for (int r = 0; r < 16; ++r) { p0[r] = 0.f; p1[r] = 0.f; }
#pragma unroll
    for (int d0 = 0; d0 < 8; ++d0) { const int cb = (d0 * 16 + hi * 8) * 2;
        const bf16x8 bq = *reinterpret_cast<const bf16x8*>(QM + kswz<256>(32 * tb + r32, cb));
        const bf16x8 a0 = *reinterpret_cast<const bf16x8*>(KM + kswz<256>(r32, cb));
        const bf16x8 a1 = *reinterpret_cast<const bf16x8*>(KM + kswz<256>(32 + r32, cb));
        p0 = MFMA32(a0, bq, p0); p1 = MFMA32(a1, bq, p1); }
    { const int t = 32 * tb + r32;
#pragma unroll
      for (int r = 0; r < 16; ++r) { const int s0 = crow(r, hi); if (s0 > t) p0[r] = 0.f; if (s0 + 32 > t) p1[r] = 0.f; } }
    bf16x8 pa0, pa1, pa2, pa3;
    PK4(p0, 0, pa0); PK4(p0, 8, pa1); PK4(p1, 0, pa2); PK4(p1, 8, pa3);
    const int vbase = (int)(uintptr_t)VI + v_rd_base(lane), kbase = (int)(uintptr_t)KT + v_rd_base(lane);
    bf16x8 v0, v1, v2, v3; vfrags<0>(vbase + vb * 512, v0, v1, v2, v3);
    { f32x16 od;
#pragma unroll
      for (int r = 0; r < 16; ++r) od[r] = 0.f;
      od = MFMA32(pa0, v0, od); od = MFMA32(pa1, v1, od); od = MFMA32(pa2, v2, od); od = MFMA32(pa3, v3, od);
#pragma unroll
      for (int r = 0; r < 16; ++r) OI[(size_t)(row0 + 32 * tb + crow(r, hi)) * 512 + h * 128 + 32 * vb + r32] = od[r]; }
#pragma unroll
    for (int e = 0; e < 2; ++e) { const int kb = 2 * (wid & 1) + e;
        bf16x8 k0, k1, k2, k3; vfrags<0>(kbase + kb * 512, k0, k1, k2, k3);
        f32x16 u;
#pragma unroll
        for (int r = 0; r < 16; ++r) u[r] = 0.f;
        u = MFMA32(v0, k0, u); u = MFMA32(v1, k1, u); u = MFMA32(v2, k2, u); u = MFMA32(v3, k3, u);
#pragma unroll
        for (int r = 0; r < 16; ++r) UT[((size_t)unit * 128 + 32 * vb + crow(r, hi)) * 128 + 32 * kb + r32] = (bf16)(cvtpk(u[r], 0.f) & 0xffffu); }
    __syncthreads();
}
DI void hgrn_h2(Frame& F) {
    bf16* UT = (bf16*)(F.ws + WS_UT); const float* DC = (const float*)(F.ws + WS_DC);
    for (int g = F.vcu * 512 + F.tid; g < 16 * 128 * 64; g += F.G * 512) {
        const int bh = g >> 13, rem = g & 8191, v = rem >> 6, kp = rem & 63;
        unsigned* base = (unsigned*)(UT + ((size_t)bh * 64 * 128 + v) * 128 + 2 * kp);
        const float* dc = DC + (size_t)bh * 64 * 128 + 2 * kp;
        float s0 = 0.f, s1 = 0.f;
        for (int c0 = 0; c0 < 64; c0 += 8) {
            unsigned u[8]; float d0[8], d1[8];
#pragma unroll
            for (int i = 0; i < 8; ++i) { u[i] = base[(size_t)(c0 + i) * 4096 * 2]; d0[i] = dc[(c0 + i) * 128]; d1[i] = dc[(c0 + i) * 128 + 1]; }
#pragma unroll
            for (int i = 0; i < 8; ++i) { base[(size_t)(c0 + i) * 4096 * 2] = pk2(s0, s1); s0 = d0[i] * s0 + bflo(u[i]); s1 = d1[i] * s1 + bfhi(u[i]); }
        }
    }
}
DI void hgrn_h3_unit(Frame& F, int unit, const float* gout) {
    using namespace att;
    const bf16* Z = (const bf16*)(F.ws + WS_Z); const bf16* QD = (const bf16*)(F.ws + WS_QD); const float* OI = (const float*)(F.ws + WS_OI); const bf16* ST = (const bf16*)(F.ws + WS_UT);
    bf16* OC = (bf16*)(F.ws + WS_XN);
    const int bh = unit >> 6, c = unit & 63, b = bh >> 2, h = bh & 3, row0 = b * SEQ + c * 64;
    unsigned char* lds = F.ldsg;
    char* SI = (char*)lds; char* QI = (char*)lds + 32768; float* PART = (float*)(lds + 49152);
    const int tid = F.tid, wid = F.wave, lane = F.lane, r32 = lane & 31, hi = lane >> 5;
#pragma unroll
    for (int i = 0; i < 4; ++i) { const int idx = tid + 512 * i, row = idx >> 4, c8 = idx & 15;
        *(v4u*)(SI + kswz<256>(row, c8 * 16)) = *(const v4u*)(ST + ((size_t)unit * 128 + row) * 128 + c8 * 8); }
#pragma unroll
    for (int i = 0; i < 2; ++i) { const int idx = tid + 512 * i, row = idx >> 4, c8 = idx & 15;
        *(v4u*)(QI + kswz<256>(row, c8 * 16)) = *(const v4u*)(QD + (size_t)(row0 + row) * 512 + h * 128 + c8 * 8); }
    __syncthreads();
    const int tb = wid & 1, vb = wid >> 1;
    f32x16 acc;
#pragma unroll
    for (int r = 0; r < 16; ++r) acc[r] = 0.f;
#pragma unroll
    for (int d0 = 0; d0 < 8; ++d0) { const int cb = (d0 * 16 + hi * 8) * 2;
        const bf16x8 a = *reinterpret_cast<const bf16x8*>(QI + kswz<256>(32 * tb + r32, cb));
        const bf16x8 bb = *reinterpret_cast<const bf16x8*>(SI + kswz<256>(32 * vb + r32, cb));
        acc = MFMA32(a, bb, acc); }
#pragma unroll
    for (int r = 0; r < 16; ++r) { const int trow = row0 + 32 * tb + crow(r, hi);
        acc[r] += OI[(size_t)trow * 512 + h * 128 + 32 * vb + r32];
        float s = acc[r] * acc[r];
        s += __shfl_xor(s, 1); s += __shfl_xor(s, 2); s += __shfl_xor(s, 4); s += __shfl_xor(s, 8); s += __shfl_xor(s, 16);
        if (r32 == 0) PART[(32 * tb + crow(r, hi)) * 4 + vb] = s; }
    __syncthreads();
    const float gv = gout[h * 128 + 32 * vb + r32];
#pragma unroll
    for (int r = 0; r < 16; ++r) { const int t = 32 * tb + crow(r, hi), trow = row0 + t;
        const f32x4 pp = *(const f32x4*)(PART + t * 4);
        const float rs = 1.f / sqrtf(((pp[0] + pp[1]) + (pp[2] + pp[3])) * (1.f / 128.f) + EPS);
        const float gt = bf2f(Z[(size_t)trow * ZE + 2304 + h * 128 + 32 * vb + r32]);
        const float sg = gt * __builtin_amdgcn_rcpf(1.f + fexp(-gt));
        OC[(size_t)trow * 1024 + 512 + h * 128 + 32 * vb + r32] = (bf16)(cvtpk(acc[r] * rs * gv * sg, 0.f) & 0xffffu); }
    __syncthreads();
}
DI void diff_combine(Frame& F, const float* lamp, const float* ghead, float linit) {
    const bf16* OD = (const bf16*)(F.ws + WS_Q); bf16* OC = (bf16*)(F.ws + WS_XN);
    const float sa = wave_sum(lamp[F.lane] * lamp[64 + F.lane]), sb = wave_sum(lamp[128 + F.lane] * lamp[192 + F.lane]);
    const float lam = fexp(sa) - fexp(sb) + linit, post = 1.f - linit;
    const int gw = F.vcu * NWAVES + F.wave, NGW = F.G * NWAVES;
    for (int m = gw; m < M; m += NGW) {
#pragma unroll
        for (int h = 0; h < 8; ++h) {
            const unsigned a = *(const unsigned*)(OD + (size_t)m * 2048 + (2 * h) * 128 + 2 * F.lane), bq = *(const unsigned*)(OD + (size_t)m * 2048 + (2 * h + 1) * 128 + 2 * F.lane);
            const float d0 = bflo(a) - lam * bflo(bq), d1 = bfhi(a) - lam * bfhi(bq);
            const float rs = post / sqrtf(wave_sum(d0 * d0 + d1 * d1) * (1.f / 128.f) + EPS);
            const float g0 = ghead[h * 128 + 2 * F.lane], g1 = ghead[h * 128 + 2 * F.lane + 1];
            *(unsigned*)(OC + (size_t)m * 1024 + h * 128 + 2 * F.lane) = pk2(d0 * rs * g0, d1 * rs * g1);
        }
    }
}

#ifndef PHASE_MASK
#define PHASE_MASK 0xFFFFF
#endif
#define EN(k) ((PHASE_MASK >> (k)) & 1)
#ifndef H1_REP
#define H1_REP 1
#endif
#ifndef PROBE_A
#define PROBE_A -1
#define PROBE_B -1
#define PROBE_N 2
#endif
#ifndef MK_PER_PHASE
#define MK_PER_PHASE 0
#endif
constexpr int N_PHASES = 1 + 4 * 6 + 2 * 6 + 2 * 5;
__global__ void __launch_bounds__(NWAVES * 64, 2) fwd_kernel(Args args) {
    extern __shared__ __attribute__((aligned(16))) unsigned char lds[];
    Frame F;
    F.lds = (LAS unsigned char*)lds; F.ldsg = lds;
    F.MISC = (volatile LAS unsigned*)(F.lds + MISC_OFF);
    F.tid = threadIdx.x; F.lane = F.tid & 63; F.wave = __builtin_amdgcn_readfirstlane(F.tid >> 6);
    F.G = gridDim.x; { const int bx = blockIdx.x; F.vcu = (F.G % 8 == 0) ? (bx % 8) * (F.G / 8) + bx / 8 : bx; }
    KA const Args* A = (KA const Args*)__builtin_amdgcn_kernarg_segment_ptr();
    F.ws = A->ws; F.ctl = (gu32*)(A->ws + WS_CTL);
    for (int u = F.tid; u < (LDS_BYTES - LDSCTL_OFF) / 4; u += NWAVES * 64) ((LAS unsigned*)(F.lds + LDSCTL_OFF))[u] = 0u;
    __syncthreads();
    const int lo = A->ph_lo, hi = A->ph_hi;
    XcdBarrier bar; bar.bar = (unsigned*)(F.ctl + CW_BAR); bar.x = 0; bar.st = nullptr;
    if (hi - lo > 1) bar = xcd_barrier_post((unsigned*)(F.ctl + CW_BAR) + A->li * XCD_BAR_WORDS, F.MISC + 8);
    int ph = 0;
#define PH_ON (ph >= lo && ph < hi)
#define PH_END do { if (ph >= lo && ph + 1 < hi) xcd_barrier(bar); ++ph; } while (0)

#define x_in ((const float*)A->in[0])
#define norm_g ((const float*)A->in[2])
#define X (A->out)
#define XN ((bf16*)(F.ws + WS_XN))
#define Y ((bf16*)(F.ws + WS_Y))
#define Zb ((bf16*)(F.ws + WS_Z))
#define W (F.ws + WS_W)
#define LAUNDER do { KA const Args* ap_ = (KA const Args*)__builtin_amdgcn_kernarg_segment_ptr(); asm volatile("" : "+s"(ap_)); A = ap_; unsigned char* w_ = ap_->ws; asm volatile("" : "+s"(w_)); F.ws = w_; int t_ = threadIdx.x; asm volatile("" : "+v"(t_)); F.tid = t_; F.lane = t_ & 63; F.wave = __builtin_amdgcn_readfirstlane(t_ >> 6); int g_ = gridDim.x, b_ = blockIdx.x; asm volatile("" : "+s"(g_), "+s"(b_)); F.G = g_; F.bx = b_; F.vcu = (g_ % 8 == 0) ? (b_ % 8) * (g_ / 8) + b_ / 8 : b_; } while (0)
    constexpr float LOG2E = 1.4426950408889634f;

    if (PH_ON && EN(0)) { LAUNDER; build_tables(F, A); convert_layer(F, A, 0); thin_rows(F, x_in, nullptr, nullptr, nullptr, 0.f, norm_g, XN); }
    PH_END;

    for (int l = 0; l < DEPTH; ++l) {
        #define g_l (norm_g + (size_t)l * 6 * D)
        for (int half = 0; half < 2; ++half) {
            if (PH_ON && EN(1)) { LAUNDER;
                pg8::Gemm g{XN, (const bf16*)(W + (half ? W_GU1 : W_GU0)), M, 2 * FF, D, D, D}; pg8::StaticOrder S; S.init(M, 2 * FF, F.G, F.bx);
                pg8::EpiSwiglu E{Zb, FF};
                pg8::gemm_phase<pg8::EpiSwiglu, pg8::StaticOrder, true, true>(F.lds + RING_OFF, g, S, E);
            }
            PH_END;
            if (PH_ON && EN(2)) { LAUNDER;
                pg8::Gemm g{Zb, (const bf16*)(W + (half ? W_D1 : W_D0)), M, D, FF, FF, FF}; pg8::StaticOrder S; S.init(M, D, F.G, F.bx);
                pg8::EpiPlain E{Y, D};
                pg8::gemm_phase<pg8::EpiPlain, pg8::StaticOrder, true, true>(F.lds + RING_OFF, g, S, E);
            }
            PH_END;
            if (PH_ON && EN(3)) { LAUNDER;
                const float* xin = (l == 0 && half == 0) ? x_in : X;
                const float* gpost = g_l + (half ? 5 : 1) * D;
                const float* gpre = half == 0 ? g_l + 2 * D : (l + 1 < DEPTH ? norm_g + (size_t)(l + 1) * 6 * D : nullptr);
                thin_rows(F, xin, X, Y, gpost, 0.5f, gpre, XN);
                if (half == 1 && l + 1 < DEPTH) convert_layer(F, A, l + 1);
            }
            PH_END;
            if (half == 0) {
                const int j = l >> 1;
                if ((l & 1) == 0) {
                    if (PH_ON && EN(4)) { LAUNDER;
                        pg8::Gemm g{XN, (const bf16*)(W + W_EIN), M, ZE, D, D, D}; pg8::StaticOrder S; S.init(M, ZE, F.G, F.bx);
                        pg8::EpiZEven E{Zb, (float*)(F.ws + WS_SP), (bf16*)(F.ws + WS_K), (const float*)(F.ws + WS_TM)};
                        pg8::gemm_phase<pg8::EpiZEven, pg8::StaticOrder, true, true>(F.lds + RING_OFF, g, S, E);
                    }
                    PH_END;
                    if (PH_ON && EN(5)) { LAUNDER;
                        LAS float* RS = (LAS float*)(F.lds + RS_OFF); LAS int* RSPM = (LAS int*)(F.lds + RS_OFF + 4096);
                        if (EN(14)) { pg8::Gemm g{Zb, (const bf16*)(W + W_EUQ), M, 768, 384, ZE, 384}; pg8::StaticOrder S; S.init(M, 768, F.G, F.bx);
                          fill_rs(F, S, (const float*)(F.ws + WS_SP), 0, 3, 1.0f / 384.0f, 0.07216878364870322f * LOG2E, RS, RSPM);
                          pg8::EpiQ E{(bf16*)(F.ws + WS_Q), RS, RSPM, (const float*)(F.ws + WS_TM)};
                          pg8::gemm_phase<pg8::EpiQ, pg8::StaticOrder, true, true>(F.lds + RING_OFF, g, S, E); }
                        __syncthreads();
                        LAUNDER;
                        if (EN(15)) { pg8::Gemm g{Zb + 384, (const bf16*)(W + W_EUKV), M, 1024, 256, ZE, 256}; pg8::StaticOrder S; S.init(M, 1024, F.G, F.bx);
                          fill_rs(F, S, (const float*)(F.ws + WS_SP), 12, 2, 1.0f / 256.0f, 1.0f, RS, RSPM);
                          pg8::EpiKV E{(bf16*)(F.ws + WS_K), (bf16*)(F.ws + WS_V), RS, RSPM};
                          pg8::gemm_phase<pg8::EpiKV, pg8::StaticOrder, true, true>(F.lds + RING_OFF, g, S, E); }
                        __syncthreads();
                        LAUNDER;
                        if (EN(16)) for (int rep_ = 0; rep_ < H1_REP; ++rep_) for (int u = F.vcu; u < 1024; u += F.G) hgrn_h1_unit(F, u, j);
                    }
                    PH_END;
                    if (PH_ON && EN(6)) { LAUNDER;
                        if (EN(17)) hgrn_h2(F);
                        LAUNDER;
                        if (EN(18))
                        for (int u = F.vcu; u < 256; u += F.G) {
                            const int st = u >> 4, qb = 15 - (u & 15), b = st >> 2, h = st & 3;
                            att::attn_unit<192>((const bf16*)(F.ws + WS_Q) + (size_t)b * SEQ * 768 + h * 192, 768, (const bf16*)(F.ws + WS_K) + (size_t)b * SEQ * 768 + h * 192, 768,
                                                (const bf16*)(F.ws + WS_V) + (size_t)b * SEQ * 512 + h * 128, 512, XN + (size_t)b * SEQ * 1024 + h * 128, 1024, qb * 256, (char*)F.ldsg);
                        }
                    }
                    PH_END;
                    if (PH_ON && EN(7)) { LAUNDER; const float* gout = (const float*)A->in[12] + j * 512; for (int u = F.vcu; u < 1024; u += F.G) hgrn_h3_unit(F, u, gout); }
                    PH_END;
                    if (PH_ON && EN(8)) { LAUNDER;
                        pg8::Gemm g{XN, (const bf16*)(W + W_EOUT), M, D, D, D, D}; pg8::StaticOrder S; S.init(M, D, F.G, F.bx);
                        pg8::EpiPlain E{Y, D};
                        pg8::gemm_phase<pg8::EpiPlain, pg8::StaticOrder, true, true>(F.lds + RING_OFF, g, S, E);
                    }
                    PH_END;
                } else {
                    if (PH_ON && EN(9)) { LAUNDER;
                        pg8::Gemm g{XN, (const bf16*)(W + W_OIN), M, ZO, D, D, D}; pg8::StaticOrder S; S.init(M, ZO, F.G, F.bx);
                        pg8::EpiZOdd E{Zb, (const float*)(F.ws + WS_TD), 0.125f * LOG2E};
                        pg8::gemm_phase<pg8::EpiZOdd, pg8::StaticOrder, true, true>(F.lds + RING_OFF, g, S, E);
                    }
                    PH_END;
                    if (PH_ON && EN(10)) { LAUNDER;
                        for (int c = F.vcu; c < 256; c += F.G) {
                            const int st = c >> 2, gq = c & 3, b = st >> 4, hc = st & 15, h = hc >> 1;
#pragma unroll 1
                            for (int k = 0; k < 4; ++k) {
                                const int qb = (k == 0) ? 15 - gq : (k == 1) ? 8 + gq : (k == 2) ? 7 - gq : gq;
                                att::attn_unit<64>(Zb + (size_t)b * SEQ * ZO + hc * 64, ZO, Zb + (size_t)b * SEQ * ZO + 1024 + hc * 64, ZO, Zb + (size_t)b * SEQ * ZO + 2048 + h * 128, ZO,
                                                   (bf16*)(F.ws + WS_Q) + (size_t)b * SEQ * 2048 + hc * 128, 2048, qb * 256, (char*)F.ldsg);
                            }
                        }
                    }
                    PH_END;
                    if (PH_ON && EN(11)) { LAUNDER; const float linit = A->linit[j]; diff_combine(F, (const float*)A->in[15] + j * 256, (const float*)A->in[16] + j * 1024, linit); }
                    PH_END;
                    if (PH_ON && EN(12)) { LAUNDER;
                        pg8::Gemm g{XN, (const bf16*)(W + W_OOUT), M, D, D, D, D}; pg8::StaticOrder S; S.init(M, D, F.G, F.bx);
                        pg8::EpiPlain E{Y, D};
                        pg8::gemm_phase<pg8::EpiPlain, pg8::StaticOrder, true, true>(F.lds + RING_OFF, g, S, E);
                    }
                    PH_END;
                }
                if (PH_ON && EN(13)) { LAUNDER; thin_rows(F, X, X, Y, g_l + 3 * D, 1.0f, g_l + 4 * D, XN); }
                PH_END;
            }
        }
    }
#undef PH_ON
#undef PH_END
#undef XN
#undef Y
#undef Zb
#undef W
#undef LAUNDER
#undef x_in
#undef norm_g
#undef X
#undef g_l
}

extern "C" void kernel_launch(void* const* d_in, const int* in_sizes, int n_in, void* d_out, int out_size, void* d_ws, size_t ws_size, hipStream_t stream) {
    static int grid = 0;
    if (grid == 0) {
        if (n_in != 18 || in_sizes[0] != M * D || out_size != M * D || ws_size < WS_END) { fprintf(stderr, "kernel_launch: unexpected shapes (n_in %d, in0 %d, out %d, ws %zu)\n", n_in, n_in > 0 ? in_sizes[0] : -1, out_size, ws_size); grid = -1; return; }
        int dev = 0, cus = 0, per_cu = 0;
        if (hipGetDevice(&dev) != hipSuccess || hipDeviceGetAttribute(&cus, hipDeviceAttributeMultiprocessorCount, dev) != hipSuccess) { grid = -1; return; }
        if (hipFuncSetAttribute((const void*)fwd_kernel, hipFuncAttributeMaxDynamicSharedMemorySize, LDS_BYTES) != hipSuccess) { fprintf(stderr, "kernel_launch: hipFuncSetAttribute failed\n"); grid = -1; return; }
        if (hipOccupancyMaxActiveBlocksPerMultiprocessor(&per_cu, (const void*)fwd_kernel, NWAVES * 64, LDS_BYTES) != hipSuccess || per_cu < 1)
            fprintf(stderr, "kernel_launch: note: occupancy query reports %d workgroups per CU\n", per_cu);
        (void)hipGetLastError();
        grid = cus;
    }
    if (grid < 0) return;
    if (hipMemsetAsync((char*)d_ws + WS_CTL, 0, CTL_ZERO_BYTES, stream) != hipSuccess) return;
    Args a{};
    for (int i = 0; i < 18; ++i) a.in[i] = d_in[i];
    a.out = (float*)d_out; a.ws = (unsigned char*)d_ws;
    for (int i = 0; i < 32; ++i) a.invf_m[i] = (float)pow(500000.0, -(double)(2 * i) / 64.0);
    for (int i = 0; i < 8; ++i) a.invf_d[i] = (float)pow(500000.0, -(double)(2 * i) / 16.0);
    for (int jj = 0; jj < 2; ++jj) a.linit[jj] = (float)(0.8 - 0.6 * exp(-0.3 * (double)(2 * jj + 1)));
#if MK_PER_PHASE
    for (int p = 0; p < N_PHASES; ++p) { a.ph_lo = p; a.ph_hi = p + 1; a.li = 0; hipLaunchKernelGGL(fwd_kernel, dim3(grid), dim3(NWAVES * 64), LDS_BYTES, stream, a); }
#else
    if (PROBE_A >= 0) {
        a.ph_lo = 0; a.ph_hi = PROBE_B + 1; a.li = 0; hipLaunchKernelGGL(fwd_kernel, dim3(grid), dim3(NWAVES * 64), LDS_BYTES, stream, a);
        for (int r = 1; r < PROBE_N; ++r) { a.ph_lo = PROBE_A; a.ph_hi = PROBE_B + 1; a.li = r; hipLaunchKernelGGL(fwd_kernel, dim3(grid), dim3(NWAVES * 64), LDS_BYTES, stream, a); }
        a.ph_lo = PROBE_A; a.ph_hi = N_PHASES; a.li = PROBE_N; hipLaunchKernelGGL(fwd_kernel, dim3(grid), dim3(NWAVES * 64), LDS_BYTES, stream, a);
    } else {
        a.ph_lo = 0; a.ph_hi = N_PHASES; a.li = 0;
        hipLaunchKernelGGL(fwd_kernel, dim3(grid), dim3(NWAVES * 64), LDS_BYTES, stream, a);
    }
#endif
    const hipError_t le = hipPeekAtLastError();
    if (le != hipSuccess) fprintf(stderr, "kernel_launch: launch failed: %s\n", hipGetErrorName(le));
}
```

```cpp
#include <hip/hip_runtime.h>
#include <cstdio>
#include <cstdint>
#include <cmath>
namespace pg8 {
#define PG8_LAS __attribute__((address_space(3)))
typedef unsigned short bf16_t;
typedef short bf16x8 __attribute__((ext_vector_type(8)));
typedef float f32x4 __attribute__((ext_vector_type(4)));
typedef unsigned u32x4 __attribute__((ext_vector_type(4)));
constexpr int BM = 256, BK = 64, HALF = 128, HTB = HALF * BK * 2  , STAGE_BYTES = 8 * HTB, NXCD = 8, WGM = 8;

__host__ __device__ __forceinline__ int lds_byte(int r, int c) { const int st = (r >> 4) * 2 + (c >> 5), rr = r & 15, cc = c & 31, ob = rr * 64 + cc * 2; return st * 1024 + (ob ^ (((ob >> 9) & 1) << 5)); }
__host__ __device__ __forceinline__ void stage_rc(int b, int& R, int& C) { const int st = b / 1024, sb = b % 1024, swz = sb ^ (((sb >> 9) & 1) << 5); R = (st >> 1) * 16 + swz / 64; C = (st & 1) * 32 + (swz % 64) / 2; }
__host__ __device__ __forceinline__ int perm32(int rho) { const int n = rho >> 4, i = rho & 15; return 8 * (i >> 2) + 4 * n + (i & 3); }

struct Unit { int pm, pn; };
struct Gemm { const bf16_t* A; const bf16_t* Bt; int M, N, K, lda, ldb; };

struct StaticOrder {
    int nM, nN, nwg, G, c;
    __host__ __device__ void init(int M, int N, int G_, int c_) { nM = M / BM; nN = N / BM; nwg = nM * nN; G = G_; c = c_; }
    __host__ __device__ bool next(int i, Unit& u) const {
        const long L = (long)i * G + c; if (L >= nwg) return false;
        int wgid = (int)L; { const int q = nwg / NXCD, r = nwg % NXCD, xcd = wgid % NXCD, off = wgid / NXCD; wgid = (xcd < r ? xcd * (q + 1) : r * (q + 1) + (xcd - r) * q) + off; }
        const int nig = WGM * nN, gid = wgid / nig, fm = gid * WGM, gsz = (nM - fm) < WGM ? (nM - fm) : WGM;
        u.pm = fm + ((wgid % nig) % gsz); u.pn = (wgid % nig) / gsz; return true;
    }
    __device__ __forceinline__ void a_ready(const Unit&) const {}
    __device__ __forceinline__ void done(const Unit&) const {}
};

typedef float f32x2_t_ __attribute__((ext_vector_type(2))); typedef __bf16 bf16x2_t_ __attribute__((ext_vector_type(2)));
__device__ __forceinline__ unsigned cvt_pk_bf16(float lo, float hi) { f32x2_t_ v = {lo, hi}; bf16x2_t_ b = __builtin_convertvector(v, bf16x2_t_); return __builtin_bit_cast(unsigned, b); }
typedef float f32x2 __attribute__((ext_vector_type(2)));
__device__ __forceinline__ float fast_exp(float x) { return __builtin_amdgcn_exp2f(x * 1.4426950408889634f); }
__device__ __forceinline__ float silu_f(float g) { return g * __builtin_amdgcn_rcpf(1.f + __builtin_amdgcn_exp2f(-1.4426950408889634f * g)); }
__device__ __forceinline__ u32x4 pack8(const f32x4 a, const f32x4 b) { u32x4 w; w.x = cvt_pk_bf16(a[0], a[1]); w.y = cvt_pk_bf16(a[2], a[3]); w.z = cvt_pk_bf16(b[0], b[1]); w.w = cvt_pk_bf16(b[2], b[3]); return w; }

#define EPI_IDS int t_ = threadIdx.x; asm volatile("" : "+v"(t_)); const int wid_ = __builtin_amdgcn_readfirstlane(t_ >> 6), wr = wid_ >> 2, wc = wid_ & 3, fr = t_ & 15, fq = (t_ & 63) >> 4; (void)wr_; (void)wc_; (void)fr_; (void)fq_
struct EpiPlain {
    static constexpr bool PERM = true, AFTER_DRAIN = false;
    bf16_t* O; int ldc;
    __device__ __forceinline__ void operator()(const f32x4 (&acc)[2][2][4][2], const Unit& u, int wr_, int wc_, int fr_, int fq_) const {
        EPI_IDS;
        const int row0 = u.pm * BM + wr * 64 + fr, col0 = u.pn * BM + wc * 32 + 8 * fq;
#pragma unroll
        for (int ai = 0; ai < 2; ++ai)
#pragma unroll
            for (int m = 0; m < 4; ++m) { bf16_t* rowp = O + (size_t)(row0 + ai * HALF + m * 16) * ldc + col0;
#pragma unroll
                for (int bj = 0; bj < 2; ++bj) *(u32x4*)(rowp + bj * HALF) = pack8(acc[ai][bj][m][0], acc[ai][bj][m][1]); }
    }
};
struct EpiSwiglu {
    static constexpr bool PERM = true, AFTER_DRAIN = false;
    bf16_t* H; int ldh;
    __device__ __forceinline__ void operator()(const f32x4 (&acc)[2][2][4][2], const Unit& u, int wr_, int wc_, int fr_, int fq_) const {
        EPI_IDS;
        const int row0 = u.pm * BM + wr * 64 + fr, col0 = u.pn * HALF + wc * 32 + 8 * fq;
#pragma unroll
        for (int ai = 0; ai < 2; ++ai)
#pragma unroll
            for (int m = 0; m < 4; ++m) {
                f32x4 h0, h1;
#pragma unroll
                for (int i = 0; i < 4; ++i) { h0[i] = silu_f(acc[ai][0][m][0][i]) * acc[ai][1][m][0][i]; h1[i] = silu_f(acc[ai][0][m][1][i]) * acc[ai][1][m][1][i]; }
                *(u32x4*)(H + (size_t)(row0 + ai * HALF + m * 16) * ldh + col0) = pack8(h0, h1);
            }
    }
};
struct EpiZEven {
    static constexpr bool PERM = true, AFTER_DRAIN = false;
    bf16_t* Z; float* SP; bf16_t* Kb; const float* TM;
    __device__ __forceinline__ void operator()(const f32x4 (&acc)[2][2][4][2], const Unit& u, int wr_, int wc_, int fr_, int fq_) const {
        EPI_IDS;
        const int row0 = u.pm * BM + wr * 64 + fr, col0 = u.pn * BM + wc * 32 + 8 * fq;
#pragma unroll
        for (int ai = 0; ai < 2; ++ai)
#pragma unroll
            for (int m = 0; m < 4; ++m) {
                const int row = row0 + ai * HALF + m * 16;
#pragma unroll
                for (int bj = 0; bj < 2; ++bj) {
                    const f32x4 v0 = acc[ai][bj][m][0], v1 = acc[ai][bj][m][1];
                    *(u32x4*)(Z + (size_t)row * 2816 + col0 + bj * HALF) = pack8(v0, v1);
                    int slot = -1;
                    if (u.pn == 0) slot = bj * 4 + wc; else if (u.pn == 1) slot = (bj == 0 ? 8 : 12) + wc; else if (u.pn == 2 && bj == 0) slot = 16 + wc;
                    if (slot >= 0) {
                        float s = (v0[0] * v0[0] + v0[1] * v0[1]) + (v0[2] * v0[2] + v0[3] * v0[3]) + (v1[0] * v1[0] + v1[1] * v1[1]) + (v1[2] * v1[2] + v1[3] * v1[3]);
                        s += __shfl_xor(s, 16); s += __shfl_xor(s, 32);
                        if (fq == 0) SP[(size_t)row * 20 + slot] = s;
                    }
                    if (u.pn == 2 && bj == 1 && wc < 2) {
                        const int j = 4 * wc + fq;
                        const f32x4 c = *(const f32x4*)(TM + (size_t)row * 64 + 4 * j), s = *(const f32x4*)(TM + (size_t)row * 64 + 32 + 4 * j);
                        const f32x4 o1 = v0 * c - v1 * s, o2 = v1 * c + v0 * s;
                        const u32x4 w = pack8(o1, o2);
#pragma unroll
                        for (int h = 0; h < 4; ++h) *(u32x4*)(Kb + (size_t)row * 768 + h * 192 + 128 + 8 * j) = w;
                    }
                }
            }
    }
};
struct EpiQ {
    static constexpr bool PERM = true, AFTER_DRAIN = false;
    bf16_t* Q; const PG8_LAS float* RS; const PG8_LAS int* RSPM; const float* TM;
    __device__ __forceinline__ void operator()(const f32x4 (&acc)[2][2][4][2], const Unit& u, int wr_, int wc_, int fr_, int fq_) const {
        EPI_IDS;
        int slot = 0;
#pragma unroll
        for (int s = 1; s < 4; ++s) if (RSPM[s] == u.pm) slot = s;
        const int rl0 = wr * 64 + fr, row0 = u.pm * BM + rl0;
#pragma unroll
        for (int ai = 0; ai < 2; ++ai)
#pragma unroll
            for (int m = 0; m < 4; ++m) {
                const int row = row0 + ai * HALF + m * 16;
                const float rs = RS[slot * 256 + rl0 + ai * HALF + m * 16];
#pragma unroll
                for (int bj = 0; bj < 2; ++bj) {
                    const f32x4 v0 = acc[ai][bj][m][0] * rs, v1 = acc[ai][bj][m][1] * rs;
                    if (u.pn < 2) {
                        const int head = 2 * u.pn + bj;
                        *(u32x4*)(Q + (size_t)row * 768 + head * 192 + wc * 32 + 8 * fq) = pack8(v0, v1);
                    } else {
                        const int head = 2 * bj + (wc >> 1), j = 4 * (wc & 1) + fq;
                        const f32x4 cs = *(const f32x4*)(TM + (size_t)row * 64 + 4 * j), sn = *(const f32x4*)(TM + (size_t)row * 64 + 32 + 4 * j);
                        const f32x4 o1 = v0 * cs - v1 * sn, o2 = v1 * cs + v0 * sn;
                        *(u32x4*)(Q + (size_t)row * 768 + head * 192 + 128 + 8 * j) = pack8(o1, o2);
                    }
                }
            }
    }
};
struct EpiKV {
    static constexpr bool PERM = true, AFTER_DRAIN = false;
    bf16_t* Kb; bf16_t* Vb; const PG8_LAS float* RS; const PG8_LAS int* RSPM;
    __device__ __forceinline__ void operator()(const f32x4 (&acc)[2][2][4][2], const Unit& u, int wr_, int wc_, int fr_, int fq_) const {
        EPI_IDS;
        int slot = 0;
#pragma unroll
        for (int s = 1; s < 4; ++s) if (RSPM[s] == u.pm) slot = s;
        const int rl0 = wr * 64 + fr, row0 = u.pm * BM + rl0;
#pragma unroll
        for (int ai = 0; ai < 2; ++ai)
#pragma unroll
            for (int m = 0; m < 4; ++m) {
                const int row = row0 + ai * HALF + m * 16;
                const float rs = RS[slot * 256 + rl0 + ai * HALF + m * 16];
                *(u32x4*)(Kb + (size_t)row * 768 + u.pn * 192 + wc * 32 + 8 * fq) = pack8(acc[ai][0][m][0] * rs, acc[ai][0][m][1] * rs);
                *(u32x4*)(Vb + (size_t)row * 512 + u.pn * 128 + wc * 32 + 8 * fq) = pack8(acc[ai][1][m][0] * rs, acc[ai][1][m][1] * rs);
            }
    }
};
struct EpiZOdd {
    static constexpr bool PERM = true, AFTER_DRAIN = false;
    bf16_t* Z; const float* TD; float qscale;
    __device__ __forceinline__ void operator()(const f32x4 (&acc)[2][2][4][2], const Unit& u, int wr_, int wc_, int fr_, int fq_) const {
        EPI_IDS;
        const int row0 = u.pm * BM + wr * 64 + fr, col0 = u.pn * BM + wc * 32 + 8 * fq;
        const bool rot = (u.pn < 8) && ((wc & 1) == 0) && (fq < 2);
        const float sc = (u.pn < 4) ? qscale : 1.0f;
#pragma unroll
        for (int ai = 0; ai < 2; ++ai)
#pragma unroll
            for (int m = 0; m < 4; ++m) {
                const int row = row0 + ai * HALF + m * 16;
                f32x4 cs = {1.f, 1.f, 1.f, 1.f}, sn = {0.f, 0.f, 0.f, 0.f};
                if (rot) { cs = *(const f32x4*)(TD + (size_t)row * 16 + 4 * fq); sn = *(const f32x4*)(TD + (size_t)row * 16 + 8 + 4 * fq); }
#pragma unroll
                for (int bj = 0; bj < 2; ++bj) {
                    const f32x4 v0 = acc[ai][bj][m][0] * sc, v1 = acc[ai][bj][m][1] * sc;
                    const f32x4 o1 = rot ? (v0 * cs - v1 * sn) : v0, o2 = rot ? (v1 * cs + v0 * sn) : v1;
                    *(u32x4*)(Z + (size_t)row * 3072 + col0 + bj * HALF) = pack8(o1, o2);
                }
            }
    }
};

template <class Epi, class Sched, bool ALIGN_EPI = false, bool SP2 = false>
__device__ __forceinline__ void gemm_phase(PG8_LAS unsigned char* lds, const Gemm g, const Sched& S, const Epi& E) {
    int tid_ = threadIdx.x; asm volatile("" : "+v"(tid_)); const int tid = tid_, wid = __builtin_amdgcn_readfirstlane(tid >> 6), lane = tid & 63, wr = wid >> 2, wc = wid & 3, fr = lane & 15, fq = lane >> 4;
    int K_ = g.K; asm volatile("" : "+s"(K_)); const int K = K_, nt = K / BK;
    unsigned voffA[2], voffB[2];
#pragma unroll
    for (int i = 0; i < 2; ++i) { int R, C; stage_rc(tid * 16 + i * 8192, R, C); const int Rb = Epi::PERM ? ((R & ~31) + perm32(R & 31)) : R;
        voffA[i] = (unsigned)(R * g.lda + C) * 2u; voffB[i] = (unsigned)(Rb * g.ldb + C) * 2u; }
    const size_t kstep = (size_t)(BK * 2);
    const size_t hA = (size_t)HALF * g.lda * 2, hB = (size_t)HALF * g.ldb * 2;
    const size_t tA = 2 * hA, tB = 2 * hB;
    const unsigned ldsw = (unsigned)wid * 1024u;
    const int aoff = lds_byte(wr * 64 + fr, fq * 8), boff = lds_byte(wc * 32 + fr, fq * 8);
#define PG8_SA(b, h) (((b) * 2 + (h)) * HTB)
#define PG8_SB(b, h) ((4 + (b) * 2 + (h)) * HTB)
#define PG8_STAGE(bufoff, gbase, voff) do { _Pragma("unroll") for (int _i = 0; _i < 2; ++_i) \
        __builtin_amdgcn_global_load_lds((const unsigned*)((const char*)(gbase) + (voff)[_i]), (PG8_LAS unsigned*)(lds + (bufoff) + ldsw + _i * 8192), 16, 0, 0); } while (0)
#define PG8_LDA(dst, b, h) do { _Pragma("unroll") for (int m = 0; m < 4; ++m) _Pragma("unroll") for (int k = 0; k < 2; ++k) dst[m][k] = *(const PG8_LAS bf16x8*)(lds + PG8_SA(b, h) + aoff + m * 2048 + k * 1024); } while (0)
#define PG8_LDB(dst, b, h) do { _Pragma("unroll") for (int n = 0; n < 2; ++n) _Pragma("unroll") for (int k = 0; k < 2; ++k) dst[n][k] = *(const PG8_LAS bf16x8*)(lds + PG8_SB(b, h) + boff + n * 2048 + k * 1024); } while (0)
#define PG8_MMA(ai, bj, At, Bt) do { __builtin_amdgcn_s_setprio(1); _Pragma("unroll") for (int m = 0; m < 4; ++m) _Pragma("unroll") for (int n = 0; n < 2; ++n) _Pragma("unroll") for (int k = 0; k < 2; ++k) \
        acc[ai][bj][m][n] = __builtin_amdgcn_mfma_f32_16x16x32_bf16(Bt[n][k], At[m][k], acc[ai][bj][m][n], 0, 0, 0); __builtin_amdgcn_s_setprio(0); } while (0)
#define PG8_WAIT_V(n) asm volatile("s_waitcnt vmcnt(" #n ")" ::: "memory")
#define PG8_WAIT_L(n) asm volatile("s_waitcnt lgkmcnt(" #n ")" ::: "memory")
#define PG8_BAR __builtin_amdgcn_s_barrier()
#define PG8_SCHED __builtin_amdgcn_sched_barrier(0)
    Unit cur, nxt; int ui = 0;
    if (!S.next(0, cur)) return;
    f32x4 acc[2][2][4][2];
#pragma unroll
    for (int a = 0; a < 2; ++a)
#pragma unroll
        for (int b = 0; b < 2; ++b)
#pragma unroll
            for (int m = 0; m < 4; ++m)
#pragma unroll
                for (int n = 0; n < 2; ++n) acc[a][b][m][n] = (f32x4){0.f, 0.f, 0.f, 0.f};
    bf16x8 At[4][2], B0[2][2], B1[2][2];
    const char* cA = (const char*)g.A + (size_t)cur.pm * tA; const char* cB = (const char*)g.Bt + (size_t)cur.pn * tB;
    S.a_ready(cur);
    if constexpr (SP2) {
        PG8_STAGE(PG8_SB(0, 0), cB, voffB); PG8_STAGE(PG8_SB(0, 1), cB + hB, voffB); PG8_STAGE(PG8_SA(0, 0), cA, voffA); PG8_STAGE(PG8_SA(0, 1), cA + hA, voffA);
        if (wr == 1) PG8_BAR;
        PG8_WAIT_V(2); PG8_BAR;
        PG8_STAGE(PG8_SB(1, 0), cB + kstep, voffB); PG8_STAGE(PG8_SA(1, 0), cA + kstep, voffA); PG8_STAGE(PG8_SB(1, 1), cB + hB + kstep, voffB);
        PG8_WAIT_V(6); PG8_BAR;
    } else {
        PG8_STAGE(PG8_SB(0, 0), cB, voffB); PG8_STAGE(PG8_SA(0, 0), cA, voffA); PG8_STAGE(PG8_SB(0, 1), cB + hB, voffB); PG8_STAGE(PG8_SA(0, 1), cA + hA, voffA);
        if (wr == 1) PG8_BAR;
        PG8_WAIT_V(4); PG8_BAR;
        PG8_STAGE(PG8_SB(1, 0), cB + kstep, voffB); PG8_STAGE(PG8_SA(1, 0), cA + kstep, voffA); PG8_STAGE(PG8_SB(1, 1), cB + hB + kstep, voffB);
        PG8_WAIT_V(6); PG8_BAR;
    }
    for (;;) {
        const bool has_next = S.next(ui + 1, nxt);
        const char* nA = has_next ? (const char*)g.A + (size_t)nxt.pm * tA : cA; const char* nB = has_next ? (const char*)g.Bt + (size_t)nxt.pn * tB : cB;
#pragma unroll 1
        for (int t = 0; t < nt; t += 2) {
            const bool last = (t == nt - 2);
            const char* a1 = cA + (size_t)(t + 1) * kstep;
            const char* a2 = last ? nA : cA + (size_t)(t + 2) * kstep; const char* b2 = last ? nB : cB + (size_t)(t + 2) * kstep;
            const char* a3 = a2 + kstep; const char* b3 = b2 + kstep;
            if (last && has_next) S.a_ready(nxt);
            if constexpr (SP2) {
            PG8_LDB(B0, 0, 0); PG8_LDB(B1, 0, 1); PG8_SCHED; PG8_LDA(At, 0, 0); PG8_STAGE(PG8_SA(1, 1), a1 + hA, voffA);
            PG8_WAIT_V(8); PG8_WAIT_L(0); PG8_BAR; PG8_MMA(0, 0, At, B0); PG8_MMA(0, 1, At, B1); PG8_BAR; PG8_SCHED;
            PG8_LDA(At, 0, 1); PG8_STAGE(PG8_SB(0, 0), b2, voffB); PG8_STAGE(PG8_SB(0, 1), b2 + hB, voffB); PG8_STAGE(PG8_SA(0, 0), a2, voffA);
            PG8_WAIT_V(8); PG8_WAIT_L(0); PG8_BAR; PG8_MMA(1, 0, At, B0); PG8_MMA(1, 1, At, B1); PG8_BAR; PG8_SCHED;
            PG8_LDB(B0, 1, 0); PG8_LDB(B1, 1, 1); PG8_SCHED; PG8_LDA(At, 1, 0); PG8_STAGE(PG8_SA(0, 1), a2 + hA, voffA);
            PG8_WAIT_V(8); PG8_WAIT_L(0); PG8_BAR; PG8_MMA(0, 0, At, B0); PG8_MMA(0, 1, At, B1); PG8_BAR; PG8_SCHED;
            PG8_LDA(At, 1, 1); PG8_STAGE(PG8_SB(1, 0), b3, voffB); PG8_STAGE(PG8_SB(1, 1), b3 + hB, voffB); PG8_STAGE(PG8_SA(1, 0), a3, voffA);
            PG8_WAIT_V(8); PG8_WAIT_L(0); PG8_BAR; PG8_MMA(1, 0, At, B0); PG8_MMA(1, 1, At, B1); PG8_BAR; PG8_SCHED;
            } else {
            PG8_LDB(B0, 0, 0); PG8_SCHED; PG8_LDA(At, 0, 0); PG8_STAGE(PG8_SA(1, 1), a1 + hA, voffA);
            PG8_WAIT_L(8); PG8_BAR; PG8_WAIT_L(0); PG8_MMA(0, 0, At, B0); PG8_BAR; PG8_SCHED;
            PG8_LDB(B1, 0, 1); PG8_STAGE(PG8_SB(0, 0), b2, voffB);
            PG8_BAR; PG8_WAIT_L(0); PG8_MMA(0, 1, At, B1); PG8_BAR;
            PG8_LDA(At, 0, 1); PG8_STAGE(PG8_SA(0, 0), a2, voffA);
            PG8_BAR; PG8_WAIT_L(0); PG8_MMA(1, 0, At, B0); PG8_BAR; PG8_SCHED;
            PG8_STAGE(PG8_SB(0, 1), b2 + hB, voffB);
            PG8_WAIT_V(6); PG8_BAR; PG8_MMA(1, 1, At, B1); PG8_BAR;
            PG8_LDB(B0, 1, 0); PG8_SCHED; PG8_LDA(At, 1, 0); PG8_STAGE(PG8_SA(0, 1), a2 + hA, voffA);
            PG8_WAIT_L(8); PG8_BAR; PG8_WAIT_L(0); PG8_MMA(0, 0, At, B0); PG8_BAR; PG8_SCHED;
            PG8_LDB(B1, 1, 1); PG8_STAGE(PG8_SB(1, 0), b3, voffB);
            PG8_BAR; PG8_WAIT_L(0); PG8_MMA(0, 1, At, B1); PG8_BAR;
            PG8_LDA(At, 1, 1); PG8_STAGE(PG8_SA(1, 0), a3, voffA);
            PG8_BAR; PG8_WAIT_L(0); PG8_MMA(1, 0, At, B0); PG8_BAR; PG8_SCHED;
            PG8_STAGE(PG8_SB(1, 1), b3 + hB, voffB);
            PG8_WAIT_V(6); PG8_BAR; PG8_MMA(1, 1, At, B1); PG8_BAR;
            }
        }
        if constexpr (ALIGN_EPI) { if (wr == 0) PG8_BAR; }
        if constexpr (!Epi::AFTER_DRAIN) { E(acc, cur, wr, wc, fr, fq); S.done(cur); }
        if (!has_next) break;
#pragma unroll
        for (int a = 0; a < 2; ++a)
#pragma unroll
            for (int b = 0; b < 2; ++b)
#pragma unroll
                for (int m = 0; m < 4; ++m)
#pragma unroll
                    for (int n = 0; n < 2; ++n) acc[a][b][m][n] = (f32x4){0.f, 0.f, 0.f, 0.f};
        cur = nxt; cA = nA; cB = nB; ++ui;
        if constexpr (ALIGN_EPI) { if (wr == 1) PG8_BAR; }
    }
    PG8_WAIT_V(0);
    if constexpr (!ALIGN_EPI) { if (wr == 0) PG8_BAR; }
    PG8_BAR;
    if constexpr (Epi::AFTER_DRAIN) { E.fused(acc, cur, wr, wc, fr, fq, lds, wid, lane); S.done(cur); }
#undef PG8_SA
#undef PG8_SB
#undef PG8_STAGE
#undef PG8_LDA
#undef PG8_LDB
#undef PG8_MMA
#undef PG8_WAIT_V
#undef PG8_WAIT_L
#undef PG8_BAR
#undef PG8_SCHED
}
}

namespace att {
typedef unsigned short bf16_t;
using bf16x8 = __attribute__((ext_vector_type(8))) short;
using s16x4  = __attribute__((ext_vector_type(4))) short;
using f32x16 = __attribute__((ext_vector_type(16))) float;
using f32x4  = __attribute__((ext_vector_type(4))) float;
using u32x4  = __attribute__((ext_vector_type(4))) unsigned;
#define ADI __device__ __forceinline__
#define SBAR() __builtin_amdgcn_sched_barrier(0)
#define MFMA32(a, b, c) __builtin_amdgcn_mfma_f32_32x32x16_bf16((a), (b), (c), 0, 0, 0)
ADI int crow(int r, int hi) { return (r & 3) + 8 * (r >> 2) + 4 * hi; }
ADI unsigned cvtpk(float lo, float hi) { return pg8::cvt_pk_bf16(lo, hi); }
ADI float bf2f(unsigned short b) { return __uint_as_float((unsigned)b << 16); }
ADI float bflo(unsigned w) { return __uint_as_float(w << 16); }
ADI float bfhi(unsigned w) { return __uint_as_float(w & 0xffff0000u); }
ADI float fexp(float x) { return __builtin_amdgcn_exp2f(x * 1.4426950408889634f); }
template <int RB> ADI int kswz(int row, int colB) { return row * RB + (colB ^ ((RB % 256 == 0 ? (row & 15) : ((row >> 1) & 7)) << 4)); }
ADI int v_st(int k, int c) { const int kk = (k & ~0xC) | ((k & 4) << 1) | ((k & 8) >> 1); return ((kk >> 3) * 4 + (c >> 5)) * 512 + ((kk & 7) * 32 + (c & 31)) * 2; }
ADI int v_rd_base(int lane) { return ((lane & 3) << 3) | (((lane >> 2) & 3) << 6) | (((lane >> 4) & 1) << 5) | (((lane >> 5) & 1) << 8); }
constexpr int v_rd_off(int d0, int ks, int half) { return d0 * 512 + ks * 4096 + half * 2048; }
template <int OFF> ADI s16x4 tr_read(int vb) { s16x4 r; asm volatile("ds_read_b64_tr_b16 %0, %1 offset:%2" : "=&v"(r) : "v"(vb), "i"(OFF) : "memory"); return r; }
#define PKLH(L, H) (bf16x8){L[0], L[1], L[2], L[3], H[0], H[1], H[2], H[3]}
template <int D0> ADI void vfrags(int vb, bf16x8& f0, bf16x8& f1, bf16x8& f2, bf16x8& f3) {
  const s16x4 l0 = tr_read<v_rd_off(D0, 0, 0)>(vb), h0 = tr_read<v_rd_off(D0, 0, 1)>(vb), l1 = tr_read<v_rd_off(D0, 1, 0)>(vb), h1 = tr_read<v_rd_off(D0, 1, 1)>(vb);
  const s16x4 l2 = tr_read<v_rd_off(D0, 2, 0)>(vb), h2 = tr_read<v_rd_off(D0, 2, 1)>(vb), l3 = tr_read<v_rd_off(D0, 3, 0)>(vb), h3 = tr_read<v_rd_off(D0, 3, 1)>(vb);
  asm volatile("s_waitcnt lgkmcnt(0)" ::: "memory"); SBAR();
  f0 = PKLH(l0, h0); f1 = PKLH(l1, h1); f2 = PKLH(l2, h2); f3 = PKLH(l3, h3);
}
template <int D0> ADI void pv_one(f32x16& od, int vb, bf16x8 pa0, bf16x8 pa1, bf16x8 pa2, bf16x8 pa3) {
  bf16x8 f0, f1, f2, f3; vfrags<D0>(vb, f0, f1, f2, f3);
  od = MFMA32(pa0, f0, od); od = MFMA32(pa1, f1, od); od = MFMA32(pa2, f2, od); od = MFMA32(pa3, f3, od);
}
#define PK4(P, BASE, OUT) do { unsigned a0_ = cvtpk(P[BASE + 0], P[BASE + 1]), a1_ = cvtpk(P[BASE + 2], P[BASE + 3]);   \
    unsigned b0_ = cvtpk(P[BASE + 4], P[BASE + 5]), b1_ = cvtpk(P[BASE + 6], P[BASE + 7]);                              \
    auto r0_ = __builtin_amdgcn_permlane32_swap(a0_, b0_, false, false); auto r1_ = __builtin_amdgcn_permlane32_swap(a1_, b1_, false, false); \
    u32x4 w_ = {r0_[0], r1_[0], r0_[1], r1_[1]}; OUT = *reinterpret_cast<bf16x8*>(&w_); } while (0)
ADI float half_swap_max(float v) { auto rr = __builtin_amdgcn_permlane32_swap(__float_as_uint(v), __float_as_uint(v), false, false); return fmaxf(__uint_as_float(rr[0]), __uint_as_float(rr[1])); }
ADI float half_swap_add(float v) { auto rr = __builtin_amdgcn_permlane32_swap(__float_as_uint(v), __float_as_uint(v), false, false); return __uint_as_float(rr[0]) + __uint_as_float(rr[1]); }

constexpr float THR2 = 11.5f;
template <int DQK>
ADI void attn_unit(const bf16_t* __restrict__ Qg, int ldq, const bf16_t* __restrict__ Kg, int ldk, const bf16_t* __restrict__ Vg, int ldv, bf16_t* __restrict__ Og, int ldo, int q0, char* lds) {
  constexpr int RB = DQK * 2, KTB = 64 * RB, ND0 = DQK / 16, NKP = DQK / 64, PPR = DQK / 8;
  int tid_ = threadIdx.x; asm volatile("" : "+v"(tid_));
  const int tid = tid_, wid = __builtin_amdgcn_readfirstlane(tid >> 6), lane = tid & 63, r32 = lane & 31, hi = lane >> 5;
  char* V_lds = lds; char* K_lds = lds + 32768;
  float* ws = (float*)(lds + 32768 + 2 * KTB) + wid * 64; float* li_l = ws; float* al_l = ws + 32;
  const int nt_unit = q0 / 64 + 4, nt_w = q0 / 64 + (wid >> 1) + 1;
  bf16x8 qr[ND0];
  { const bf16_t* Qw = Qg + (size_t)(q0 + wid * 32 + r32) * ldq + hi * 8;
#pragma unroll
    for (int d0 = 0; d0 < ND0; ++d0) qr[d0] = *reinterpret_cast<const bf16x8*>(Qw + d0 * 16); }
  const int sr = tid >> 4, sc = (tid & 15) * 8, vst0 = v_st(sr, sc), vst1 = v_st(32 + sr, sc);
  int krow[NKP], kcb[NKP];
#pragma unroll
  for (int i = 0; i < NKP; ++i) { const int idx = tid + 512 * i; krow[i] = idx / PPR; kcb[i] = (idx % PPR) * 16; }
  const int vb0 = (int)(uintptr_t)V_lds + v_rd_base(lane);
  bf16x8 vs0, vs1, ks[NKP];
#define ALOAD(k0) do { vs0 = *reinterpret_cast<const bf16x8*>(Vg + (size_t)((k0) + sr) * ldv + sc); vs1 = *reinterpret_cast<const bf16x8*>(Vg + (size_t)((k0) + 32 + sr) * ldv + sc); \
    _Pragma("unroll") for (int i_ = 0; i_ < NKP; ++i_) ks[i_] = *reinterpret_cast<const bf16x8*>(Kg + (size_t)((k0) + krow[i_]) * ldk + (kcb[i_] >> 1)); } while (0)
#define AWRITE(b) do { *(bf16x8*)(V_lds + (b) * 16384 + vst0) = vs0; *(bf16x8*)(V_lds + (b) * 16384 + vst1) = vs1; \
    _Pragma("unroll") for (int i_ = 0; i_ < NKP; ++i_) *(bf16x8*)(K_lds + (b) * KTB + kswz<RB>(krow[i_], kcb[i_])) = ks[i_]; } while (0)
  float m_reg = -1e30f, l_reg = 0.f; f32x16 o[4];
#pragma unroll
  for (int d = 0; d < 4; ++d)
#pragma unroll
    for (int r = 0; r < 16; ++r) o[d][r] = 0.f;
  ALOAD(0); AWRITE(0); __syncthreads();
  for (int j = 0; j < nt_unit; ++j) {
    const int buf = j & 1;
    if (j + 1 < nt_unit) ALOAD((j + 1) * 64);
    if (j < nt_w) {
      const char* Ks = K_lds + buf * KTB;
      f32x16 p0, p1;
#pragma unroll
      for (int r = 0; r < 16; ++r) { p0[r] = 0.f; p1[r] = 0.f; }
#pragma unroll
      for (int d0 = 0; d0 < ND0; ++d0) { const int cb = (d0 * 16 + hi * 8) * 2;
        const bf16x8 b0 = *reinterpret_cast<const bf16x8*>(Ks + kswz<RB>(r32, cb));
        const bf16x8 b1 = *reinterpret_cast<const bf16x8*>(Ks + kswz<RB>(32 + r32, cb));
        p0 = MFMA32(b0, qr[d0], p0); p1 = MFMA32(b1, qr[d0], p1);
        if ((d0 & 3) == 3) SBAR(); }
      float pmax = p0[0];
#pragma unroll
      for (int r = 1; r < 16; ++r) pmax = fmaxf(pmax, p0[r]);
#pragma unroll
      for (int r = 0; r < 16; ++r) pmax = fmaxf(pmax, p1[r]);
      pmax = half_swap_max(pmax);
      float mn, alpha;
      if (__all(pmax - m_reg <= THR2)) { mn = m_reg; alpha = 1.f; }
      else { mn = fmaxf(m_reg, pmax); alpha = __builtin_amdgcn_exp2f(m_reg - mn); m_reg = mn; }
      float ps = 0.f;
#pragma unroll
      for (int r = 0; r < 16; ++r) { p0[r] = __builtin_amdgcn_exp2f(p0[r] - mn); p1[r] = __builtin_amdgcn_exp2f(p1[r] - mn); ps += p0[r] + p1[r]; }
      ps = half_swap_add(ps);
      l_reg = l_reg * alpha + ps;
      bf16x8 pa0, pa1, pa2, pa3;
      PK4(p0, 0, pa0); PK4(p0, 8, pa1); PK4(p1, 0, pa2); PK4(p1, 8, pa3);
      if (__any(alpha < 1.f)) { if (hi == 0) al_l[r32] = alpha; asm volatile("s_waitcnt lgkmcnt(0)" ::: "memory");
#pragma unroll
        for (int r = 0; r < 16; ++r) { const float a = al_l[crow(r, hi)];
#pragma unroll
          for (int d = 0; d < 4; ++d) o[d][r] *= a; }
        asm volatile("s_waitcnt lgkmcnt(0)" ::: "memory"); }
      const int vb = vb0 + buf * 16384;
      pv_one<0>(o[0], vb, pa0, pa1, pa2, pa3); pv_one<1>(o[1], vb, pa0, pa1, pa2, pa3); pv_one<2>(o[2], vb, pa0, pa1, pa2, pa3); pv_one<3>(o[3], vb, pa0, pa1, pa2, pa3);
    }
    if (j + 1 < nt_unit) AWRITE(buf ^ 1);
    __syncthreads();
  }
  if (hi == 0) li_l[r32] = l_reg; asm volatile("s_waitcnt lgkmcnt(0)" ::: "memory");
  bf16_t* Ow = Og + (size_t)(q0 + wid * 32) * ldo;
#pragma unroll
  for (int r = 0; r < 16; ++r) { const int orow = crow(r, hi); const float rl = __builtin_amdgcn_rcpf(li_l[orow]);
#pragma unroll
    for (int d0 = 0; d0 < 4; ++d0) Ow[(size_t)orow * ldo + d0 * 32 + r32] = (bf16_t)(cvtpk(o[d0][r] * rl, 0.f) & 0xffffu); }
  asm volatile("s_waitcnt lgkmcnt(0)" ::: "memory");
#undef ALOAD
#undef AWRITE
}
}

#define GAS __attribute__((address_space(1)))
#define LAS __attribute__((address_space(3)))
typedef unsigned short bf16;
typedef unsigned v4u __attribute__((ext_vector_type(4)));
typedef float f32x4 __attribute__((ext_vector_type(4)));
typedef short bf16x8 __attribute__((ext_vector_type(8)));
typedef GAS unsigned gu32;
typedef GAS unsigned long long gu64;
#define RLX_AGENT __ATOMIC_RELAXED, __HIP_MEMORY_SCOPE_AGENT
#define LDS_WAIT() asm volatile("s_waitcnt lgkmcnt(0)" ::: "memory")
#define VM_WAIT() asm volatile("s_waitcnt vmcnt(0)" ::: "memory")
#define DI __device__ __forceinline__
DI unsigned f2bf(float f) { unsigned u = __builtin_bit_cast(unsigned, f); return (u + 0x7fffu + ((u >> 16) & 1u)) >> 16; }
DI unsigned pk2(float lo, float hi) { return f2bf(lo) | (f2bf(hi) << 16); }

constexpr int NWAVES = 8;
constexpr int M = 16384, D = 1024, FF = 2816, SEQ = 4096, NB = 4, DEPTH = 4;
constexpr int ZE = 2816, ZO = 3072;
constexpr float EPS = 1e-6f;
constexpr size_t MiB = 1u << 20;
constexpr size_t WS_CTL = 0, CTL_ZERO_BYTES = 1 * MiB;
constexpr size_t WS_LB = 1 * MiB;
constexpr size_t WS_TM = 2 * MiB;
constexpr size_t WS_TD = 6 * MiB;
constexpr size_t WS_W = 8 * MiB;
constexpr size_t W_GU0 = 0, W_D0 = 11534336, W_GU1 = 17301504, W_D1 = 28835840, W_MIX = 34603008;
constexpr size_t W_EIN = W_MIX, W_EUQ = W_MIX + 5767168, W_EUKV = W_EUQ + 589824, W_EOUT = W_EUKV + 524288;
constexpr size_t W_OIN = W_MIX, W_OOUT = W_MIX + 6291456;
constexpr size_t WS_XN = 50 * MiB;
constexpr size_t WS_Y = 82 * MiB;
constexpr size_t WS_Z = 114 * MiB;
constexpr size_t WS_Q = 210 * MiB, WS_K = 234 * MiB, WS_V = 258 * MiB;
constexpr size_t WS_UT = 274 * MiB;
constexpr size_t WS_OI = 306 * MiB;
constexpr size_t WS_QD = 338 * MiB;
constexpr size_t WS_DC = 354 * MiB;
constexpr size_t WS_SP = 355 * MiB;
constexpr size_t WS_END = 357 * MiB;
constexpr int CW_BAR = 4096;
constexpr int RING_OFF = 0, RING_BYTES = 131072;
constexpr int LDSCTL_OFF = RING_BYTES, MISC_OFF = LDSCTL_OFF + 320;
constexpr int LDS_BYTES = 147456;
constexpr int RS_OFF = 132096;

#define XB_TMO      128
#define XB_XCNT(j)  (256  + 64 * (j))
#define XB_XSUB(j)  (1280 + 64 * (j))
#define XB_XGEN(j)  (2304 + 64 * (j))
#define XB_TOP      3328
#define XB_TOPGEN   3392
#define XCD_BAR_WORDS 3456
#define XB_SPIN_CAP (1u << 21)

__device__ __forceinline__ unsigned xb_ld(unsigned* p)              { return __hip_atomic_load(p, __ATOMIC_RELAXED, __HIP_MEMORY_SCOPE_AGENT); }
__device__ __forceinline__ unsigned xb_add(unsigned* p, unsigned v) { return __hip_atomic_fetch_add(p, v, __ATOMIC_RELAXED, __HIP_MEMORY_SCOPE_AGENT); }
__device__ __forceinline__ unsigned xb_xcc_id() { return (unsigned)__builtin_amdgcn_s_getreg((3 << 11) | 20) & 0xFu; }
#define XB_SPIN(cond, bar) do { unsigned _sp = 0; while (cond) { __builtin_amdgcn_s_sleep(1); \
    if ((++_sp & 255u) == 0u) { if (xb_ld(&(bar)[XB_TMO])) break; if (_sp > XB_SPIN_CAP) { atomicAdd(&(bar)[XB_TMO], 1u); break; } } } } while (0)

struct XcdBarrier {
    unsigned* bar; unsigned x;
    volatile LAS unsigned* st;
};

__device__ __forceinline__ XcdBarrier xcd_barrier_post(unsigned* bar, volatile LAS unsigned* st) {
    XcdBarrier b; b.bar = bar; b.x = xb_xcc_id(); b.st = st;
    if (threadIdx.x == 0) (void)xb_add(&bar[XB_XCNT(b.x)], 1u);
    return b;
}
__device__ __forceinline__ void xcd_barrier_complete(unsigned* bar, unsigned x, unsigned& nloc, unsigned& nx) {
    const unsigned G = gridDim.x * gridDim.y * gridDim.z;
    unsigned sum, cnt, mine, sp = 0u;
    for (;;) {
        sum = 0u; cnt = 0u; mine = 0u;
#pragma unroll
        for (unsigned j = 0; j < 16; ++j) { const unsigned c = xb_ld(&bar[XB_XCNT(j)]); sum += c; cnt += (c > 0u) ? 1u : 0u; mine = (j == x) ? c : mine; }
        if (sum == G) break;
        __builtin_amdgcn_s_sleep(1);
        if ((++sp & 255u) == 0u) { if (xb_ld(&bar[XB_TMO])) break; if (sp > XB_SPIN_CAP) { atomicAdd(&bar[XB_TMO], 1u); break; } }
    }
    nloc = mine > 0u ? mine : 1u; nx = cnt > 0u ? cnt : 1u;
}

__device__ __forceinline__ void xcd_barrier(const XcdBarrier& b) {
    asm volatile("s_waitcnt vmcnt(0)" ::: "memory");
    __syncthreads();
    if (threadIdx.x == 0) {
        unsigned* bar = b.bar;
        __builtin_amdgcn_s_waitcnt(0);
        unsigned nloc = b.st[0], nx = b.st[1];
        if (nloc == 0u) { xcd_barrier_complete(bar, b.x, nloc, nx); b.st[0] = nloc; b.st[1] = nx; }
        const unsigned old = xb_add(&bar[XB_XSUB(b.x)], 1u);
        const unsigned gen = old / nloc;
        if (old + 1u == (gen + 1u) * nloc) {
            __builtin_amdgcn_fence(__ATOMIC_RELEASE, "agent");
            asm volatile("s_waitcnt vmcnt(0)" ::: "memory");
            const unsigned og = xb_add(&bar[XB_TOP], 1u);
            const unsigned tg = og / nx;
            if (og + 1u == (tg + 1u) * nx) xb_add(&bar[XB_TOPGEN], 1u);
            else XB_SPIN(xb_ld(&bar[XB_TOPGEN]) == tg, bar);
            __builtin_amdgcn_fence(__ATOMIC_ACQUIRE, "agent");
            xb_add(&bar[XB_XGEN(b.x)], 1u);
            asm volatile("s_waitcnt vmcnt(0)" ::: "memory");
        } else {
            XB_SPIN(xb_ld(&bar[XB_XGEN(b.x)]) == gen, bar);
            __builtin_amdgcn_fence(__ATOMIC_ACQUIRE, "agent");
            asm volatile("s_waitcnt vmcnt(0)" ::: "memory");
        }
    }
    __syncthreads();
}


struct Args { const void* in[18]; float* out; unsigned char* ws; float invf_m[32]; float invf_d[8]; float linit[2]; int ph_lo, ph_hi, li, pad; };
#define KA __attribute__((address_space(4)))
struct Frame {
    LAS unsigned char* lds; unsigned char* ldsg;
    volatile LAS unsigned* MISC;
    gu32* ctl;
    int tid, lane, wave, vcu, G, bx;
    unsigned char* ws;
};
DI float wave_sum(float v) {
#pragma unroll
    for (int o = 1; o < 64; o <<= 1) v += __shfl_xor(v, o);
    return v;
}
using att::bflo; using att::bfhi; using att::fexp; using att::bf2f;

enum { CV_GU = 0, CV_ID = 1, CV_EIN = 2, CV_EUQ = 3, CV_OIN = 4 };
DI void map_col(int kind, int n, int& col, int& which) {
    which = 0; col = n;
    if (kind == CV_GU) { const int pn = n >> 8, r = n & 255; which = (r < 128) ? 0 : 1; col = pn * 128 + (r & 127); }
    else if (kind == CV_EIN) {
        if (n < 640) col = n;
        else if (n < 704) { const int p = n - 640, j = p >> 3, nn = (p >> 2) & 1, i = p & 3; col = 640 + 32 * nn + 4 * j + i; }
        else if (n < 768) { which = -1; col = 0; }
        else col = n - 64;
    } else if (kind == CV_EUQ) {
        if (n < 512) { col = (n >> 7) * 192 + (n & 127); }
        else { const int r = n - 512, head = r >> 6, p = r & 63, j = p >> 3, nn = (p >> 2) & 1, i = p & 3; col = head * 192 + 128 + 32 * nn + 4 * j + i; }
    } else if (kind == CV_OIN) {
        if (n < 2048) { const int p = n & 63; if (p < 16) { const int j = p >> 3, nn = (p >> 2) & 1, i = p & 3; col = (n & ~63) + 8 * nn + 4 * j + i; } }
    }
}
DI void cvt_item(int kind, const float* a, const float* b, const float* scale, int ld, int K, int Ndst, bf16* WT, LAS float* scr, int item, int lane) {
    const int nblk = Ndst / 32, kb = item / nblk, nb = item % nblk, k0 = 64 * kb, n0 = 32 * nb;
    int col, which; map_col(kind, n0 + (lane & 31), col, which);
    const float* src = (which == 1) ? b : a;
#pragma unroll 8
    for (int i = 0; i < 32; ++i) { const int kk = 2 * i + (lane >> 5); float v = 0.f;
        if (which >= 0) { v = src[(size_t)(k0 + kk) * ld + col]; if (scale) v *= scale[k0 + kk]; }
        scr[kk * 33 + (lane & 31)] = v; }
    LDS_WAIT(); asm volatile("" ::: "memory");
    const int c = lane & 7;
#pragma unroll
    for (int j = 0; j < 4; ++j) { const int n = (lane >> 3) + 8 * j; const LAS float* s = scr + (8 * c) * 33 + n;
        v4u o; o.x = pk2(s[0 * 33], s[1 * 33]); o.y = pk2(s[2 * 33], s[3 * 33]); o.z = pk2(s[4 * 33], s[5 * 33]); o.w = pk2(s[6 * 33], s[7 * 33]);
        *(GAS v4u*)(WT + (size_t)(n0 + n) * K + k0 + 8 * c) = o; }
    LDS_WAIT(); asm volatile("" ::: "memory");
}
DI void convert_layer(Frame& F, KA const Args* A, int l) {
    LAS float* scr = (LAS float*)(F.lds + RING_OFF + F.wave * 16384);
    const int gw = F.vcu * NWAVES + F.wave, NGW = F.G * NWAVES;
    unsigned char* W = F.ws + WS_W;
    const float* wg = (const float*)A->in[3]; const float* wu = (const float*)A->in[4]; const float* wd = (const float*)A->in[5];
    constexpr int I_GU = 16 * 176, I_D = 44 * 32, I_EIN = 16 * 88, I_EUQ = 6 * 24, I_EUKV = 4 * 32, I_OUT = 16 * 32, I_OIN = 16 * 96;
    const bool even = (l & 1) == 0; const int j = l >> 1;
    const int nmix = even ? (I_EIN + I_EUQ + I_EUKV + I_OUT) : (I_OIN + I_OUT);
    const int total = 2 * (I_GU + I_D) + nmix;
    for (int it = gw; it < total; it += NGW) {
        int r = it;
        if (r < 2 * (I_GU + I_D)) {
            const int s = r / (I_GU + I_D); r -= s * (I_GU + I_D);
            const size_t wo = (size_t)(l * 2 + s) * 1024 * 2816;
            if (r < I_GU) cvt_item(CV_GU, wg + wo, wu + wo, nullptr, 2816, 1024, 5632, (bf16*)(W + (s ? W_GU1 : W_GU0)), scr, r, F.lane);
            else cvt_item(CV_ID, wd + wo, nullptr, nullptr, 1024, 2816, 1024, (bf16*)(W + (s ? W_D1 : W_D0)), scr, r - I_GU, F.lane);
            continue;
        }
        r -= 2 * (I_GU + I_D);
        if (even) {
            if (r < I_EIN) { cvt_item(CV_EIN, (const float*)A->in[6] + (size_t)j * 1024 * 2752, nullptr, nullptr, 2752, 1024, 2816, (bf16*)(W + W_EIN), scr, r, F.lane); continue; } r -= I_EIN;
            if (r < I_EUQ) { cvt_item(CV_EUQ, (const float*)A->in[8] + (size_t)j * 384 * 768, nullptr, (const float*)A->in[7] + j * 384, 768, 384, 768, (bf16*)(W + W_EUQ), scr, r, F.lane); continue; } r -= I_EUQ;
            if (r < I_EUKV) { cvt_item(CV_ID, (const float*)A->in[10] + (size_t)j * 256 * 1024, nullptr, (const float*)A->in[9] + j * 256, 1024, 256, 1024, (bf16*)(W + W_EUKV), scr, r, F.lane); continue; } r -= I_EUKV;
            cvt_item(CV_ID, (const float*)A->in[13] + (size_t)j * 1024 * 1024, nullptr, nullptr, 1024, 1024, 1024, (bf16*)(W + W_EOUT), scr, r, F.lane);
        } else {
            if (r < I_OIN) { cvt_item(CV_OIN, (const float*)A->in[14] + (size_t)j * 1024 * 3072, nullptr, nullptr, 3072, 1024, 3072, (bf16*)(W + W_OIN), scr, r, F.lane); continue; } r -= I_OIN;
            cvt_item(CV_ID, (const float*)A->in[17] + (size_t)j * 1024 * 1024, nullptr, nullptr, 1024, 1024, 1024, (bf16*)(W + W_OOUT), scr, r, F.lane);
        }
    }
}
constexpr int TR = 4;
DI void thin_rows(Frame& F, const float* xin, float* xout, const bf16* Y, const float* gpost, float c, const float* gpre, bf16* XN) {
    const int gw = F.vcu * NWAVES + F.wave, NGW = F.G * NWAVES;
    f32x4 gp[4], gq[4];
#pragma unroll
    for (int j = 0; j < 4; ++j) { gp[j] = Y ? *((const GAS f32x4*)gpost + F.lane + 64 * j) : (f32x4){0.f, 0.f, 0.f, 0.f}; gq[j] = gpre ? *((const GAS f32x4*)gpre + F.lane + 64 * j) : (f32x4){0.f, 0.f, 0.f, 0.f}; }
    for (int m0 = gw; m0 < M; m0 += TR * NGW) {
        f32x4 x[TR][4]; unsigned long long yw[TR][4];
#pragma unroll
        for (int r = 0; r < TR; ++r) { const int m = m0 + r * NGW; if (m < M) {
            const GAS f32x4* xr = (const GAS f32x4*)(xin + (size_t)m * D) + F.lane;
#pragma unroll
            for (int j = 0; j < 4; ++j) x[r][j] = __builtin_nontemporal_load(xr + 64 * j);
            if (Y) { const GAS unsigned long long* yr = (const GAS unsigned long long*)(Y + (size_t)m * D) + F.lane;
#pragma unroll
                for (int j = 0; j < 4; ++j) yw[r][j] = __builtin_nontemporal_load(yr + 64 * j); } } }
#pragma unroll
        for (int r = 0; r < TR; ++r) { const int m = m0 + r * NGW; if (m < M) {
            if (Y) {
                f32x4 y[4]; float ss = 0.f;
#pragma unroll
                for (int j = 0; j < 4; ++j) { const unsigned lo = (unsigned)yw[r][j], hi = (unsigned)(yw[r][j] >> 32);
                    y[j] = (f32x4){bflo(lo), bfhi(lo), bflo(hi), bfhi(hi)}; ss += (y[j].x * y[j].x + y[j].y * y[j].y) + (y[j].z * y[j].z + y[j].w * y[j].w); }
                const float rs = c / sqrtf(wave_sum(ss) * (1.f / D) + EPS);
                GAS f32x4* xo = (GAS f32x4*)(xout + (size_t)m * D) + F.lane;
#pragma unroll
                for (int j = 0; j < 4; ++j) { x[r][j] = x[r][j] + y[j] * gp[j] * rs; __builtin_nontemporal_store(x[r][j], xo + 64 * j); }
            }
            if (gpre) {
                float ss2 = 0.f;
#pragma unroll
                for (int j = 0; j < 4; ++j) ss2 += (x[r][j].x * x[r][j].x + x[r][j].y * x[r][j].y) + (x[r][j].z * x[r][j].z + x[r][j].w * x[r][j].w);
                const float rs2 = 1.f / sqrtf(wave_sum(ss2) * (1.f / D) + EPS);
                GAS unsigned long long* o8 = (GAS unsigned long long*)(XN + (size_t)m * D) + F.lane;
#pragma unroll
                for (int j = 0; j < 4; ++j) { const f32x4 v = x[r][j] * gq[j] * rs2;
                    __builtin_nontemporal_store((unsigned long long)pk2(v.x, v.y) | ((unsigned long long)pk2(v.z, v.w) << 32), o8 + 64 * j); }
            } } }
    }
}
DI void build_tables(Frame& F, KA const Args* A) {
    const int* pos = (const int*)A->in[1];
    float* TM = (float*)(F.ws + WS_TM); float* TD = (float*)(F.ws + WS_TD); float* LB = (float*)(F.ws + WS_LB);
    const int gt = F.vcu * 512 + F.tid, NT = F.G * 512;
    for (int idx = gt; idx < M * 40; idx += NT) {
        const int row = idx / 40, i = idx % 40;
        const float p = (float)pos[row];
        const float invf = (i < 32) ? A->invf_m[i] : A->invf_d[i - 32];
        const float ang = p * invf;
        const double rev = (double)ang * 0.15915494309189533577;
        const float fr = (float)(rev - __builtin_rint(rev));
        const float cs = __builtin_amdgcn_cosf(fr), sn = __builtin_amdgcn_sinf(fr);
        if (i < 32) { TM[(size_t)row * 64 + i] = cs; TM[(size_t)row * 64 + 32 + i] = sn; }
        else { TD[(size_t)row * 16 + (i - 32)] = cs; TD[(size_t)row * 16 + 8 + (i - 32)] = sn; }
    }
    const float* lg = (const float*)A->in[11];
    for (int i = gt; i < 512; i += NT) {
        const float l0 = lg[i], l1 = lg[512 + i], mx = fmaxf(l0, l1), e0 = fexp(l0 - mx), e1 = fexp(l1 - mx), w0 = e0 / (e0 + e1), w1 = e1 / (e0 + e1);
        LB[i] = w0 - w0; LB[512 + i] = (w0 + w1) - w0;
    }
}

DI void fill_rs(Frame& F, const pg8::StaticOrder& S, const float* SP, int off, int cnt4, float inv_n, float scale, LAS float* RS, LAS int* RSPM) {
    pg8::Unit u;
    if (F.tid < 4) RSPM[F.tid] = -1;
    __syncthreads();
    for (int i = 0; i < 4; ++i) { if (!S.next(i, u)) break;
        if (F.tid == 0) RSPM[i] = u.pm;
        if (F.tid < 256) { const float* p = SP + (size_t)(u.pm * 256 + F.tid) * 20 + off; float ss = 0.f;
            for (int c = 0; c < cnt4; ++c) { const f32x4 a = *(const f32x4*)(p + 4 * c); ss += (a[0] + a[1]) + (a[2] + a[3]); }
            RS[i * 256 + F.tid] = scale / sqrtf(ss * inv_n + EPS); } }
    __syncthreads();
}
DI void hgrn_h1_unit(Frame& F, int unit, int j) {
    using namespace att;
    const bf16* Z = (const bf16*)(F.ws + WS_Z); const float* LBt = (const float*)(F.ws + WS_LB) + j * 512;
    bf16* QD = (bf16*)(F.ws + WS_QD); float* OI = (float*)(F.ws + WS_OI); bf16* UT = (bf16*)(F.ws + WS_UT); float* DC = (float*)(F.ws + WS_DC);
    const int bh = unit >> 6, c = unit & 63, b = bh >> 2, h = bh & 3, row0 = b * SEQ + c * 64;
    unsigned char* lds = F.ldsg;
    constexpr int LP = 132;
    float* L = (float*)lds; float* SEG = (float*)(lds + 33792);
    char* QM = (char*)lds + 36864; char* KM = (char*)lds + 53248; char* KT = (char*)lds + 69632; char* VI = (char*)lds + 86016;
    const int tid = F.tid, wid = F.wave, lane = F.lane, r32 = lane & 31, hi = lane >> 5;
    const int sr = tid >> 4, sc = (tid & 15) * 8;
    float kk[2][8];
#pragma unroll
    for (int e = 0; e < 2; ++e) { const int rr = sr + 32 * e;
        const v4u zf = *(const v4u*)(Z + (size_t)(row0 + rr) * ZE + 1280 + h * 128 + sc);
        const f32x4 lb0 = *(const f32x4*)(LBt + h * 128 + sc), lb1 = *(const f32x4*)(LBt + h * 128 + sc + 4);
        float zv[8] = {bflo(zf.x), bfhi(zf.x), bflo(zf.y), bfhi(zf.y), bflo(zf.z), bfhi(zf.z), bflo(zf.w), bfhi(zf.w)};
        float lf[8];
#pragma unroll
        for (int i = 0; i < 8; ++i) { const float lb = (i < 4) ? lb0[i & 3] : lb1[i & 3];
            const float sig = __builtin_amdgcn_rcpf(1.f + fexp(-zv[i]));
            const float f = lb + (1.f - lb) * sig;
            lf[i] = __builtin_amdgcn_logf(fmaxf(f, 1e-30f)) * 0.69314718055994531f;
            kk[e][i] = (1.f - lb) * (1.f - sig); }
        *(f32x4*)(L + rr * LP + sc) = (f32x4){lf[0], lf[1], lf[2], lf[3]}; *(f32x4*)(L + rr * LP + sc + 4) = (f32x4){lf[4], lf[5], lf[6], lf[7]};
    }
    __syncthreads();
    { const int col = tid & 127, seg = tid >> 7; float run = 0.f;
#pragma unroll
      for (int i = 0; i < 16; ++i) { run += L[(16 * seg + i) * LP + col]; L[(16 * seg + i) * LP + col] = run; }
      SEG[seg * 128 + col] = run;
      __syncthreads();
      float off = 0.f;
#pragma unroll
      for (int s = 0; s < 3; ++s) off += (s < seg) ? SEG[s * 128 + col] : 0.f;
#pragma unroll
      for (int i = 0; i < 16; ++i) L[(16 * seg + i) * LP + col] += off;
    }
    __syncthreads();
#pragma unroll
    for (int e = 0; e < 2; ++e) { const int rr = sr + 32 * e;
        const v4u zq = *(const v4u*)(Z + (size_t)(row0 + rr) * ZE + 768 + h * 128 + sc);
        const v4u zi = *(const v4u*)(Z + (size_t)(row0 + rr) * ZE + 1792 + h * 128 + sc);
        float q[8] = {bflo(zq.x), bfhi(zq.x), bflo(zq.y), bfhi(zq.y), bflo(zq.z), bfhi(zq.z), bflo(zq.w), bfhi(zq.w)};
        float qm[8], km[8], kt[8], qd[8];
#pragma unroll
        for (int i = 0; i < 8; ++i) { const float bc = L[rr * LP + sc + i], bl = L[63 * LP + sc + i], rf = L[31 * LP + sc + i];
            qm[i] = q[i] * fexp(bc - rf); km[i] = kk[e][i] * fexp(rf - bc); kt[i] = kk[e][i] * fexp(bl - bc); qd[i] = q[i] * fexp(bc); }
        *(v4u*)(QM + kswz<256>(rr, sc * 2)) = (v4u){cvtpk(qm[0], qm[1]), cvtpk(qm[2], qm[3]), cvtpk(qm[4], qm[5]), cvtpk(qm[6], qm[7])};
        *(v4u*)(KM + kswz<256>(rr, sc * 2)) = (v4u){cvtpk(km[0], km[1]), cvtpk(km[2], km[3]), cvtpk(km[4], km[5]), cvtpk(km[6], km[7])};
        *(v4u*)(KT + v_st(rr, sc)) = (v4u){cvtpk(kt[0], kt[1]), cvtpk(kt[2], kt[3]), cvtpk(kt[4], kt[5]), cvtpk(kt[6], kt[7])};
        *(v4u*)(VI + v_st(rr, sc)) = zi;
        *(v4u*)(QD + (size_t)(row0 + rr) * 512 + h * 128 + sc) = (v4u){cvtpk(qd[0], qd[1]), cvtpk(qd[2], qd[3]), cvtpk(qd[4], qd[5]), cvtpk(qd[6], qd[7])};
    }
    if (tid < 128) DC[(size_t)unit * 128 + tid] = fexp(L[63 * LP + tid]);
    __syncthreads();
    const int tb = wid & 1, vb = wid >> 1;
    f32x16 p0, p1;
#pragma unroll
    for (int r = 0; r < 16; ++r) { p0[r] = 0.f; p1[r] = 0.f; }
#pragma unroll
    for (int d0 = 0; d0 < 8; ++d0) { const int cb = (d0 * 16 + hi * 8) * 2;
        const bf16x8 bq = *reinterpret_cast<const bf16x8*>(QM + kswz<256>(32 * tb + r32, cb));
        const bf16x8 a0 = *reinterpret_cast<const bf16x8*>(KM + kswz<256>(r32, cb));
        const bf16x8 a1 = *reinterpret_cast<const bf16x8*>(KM + kswz<256>(32 + r32, cb));
        p0 = MFMA32(a0, bq, p0); p1 = MFMA32(a1, bq, p1); }
    { const int t = 32 * tb + r32;
#pragma unroll
      for (int r = 0; r < 16; ++r) { const int s0 = crow(r, hi); if (s0 > t) p0[r] = 0.f; if (s0 + 32 > t) p1[r] = 0.f; } }
    bf16x8 pa0, pa1, pa2, pa3;
    PK4(p0, 0, pa0); PK4(p0, 8, pa1); PK4(p1, 0, pa2); PK4(p1, 8, pa3);
    const int vbase = (int)(uintptr_t)VI + v_rd_base(lane), kbase = (int)(uintptr_t)KT + v_rd_base(lane);
    bf16x8 v0, v1, v2, v3; vfrags<0>(vbase + vb * 512, v0, v1, v2, v3);
    { f32x16 od;
#pragma unroll
      for (int r = 0; r < 16; ++r) od[r] = 0.f;
      od = MFMA32(pa0, v0, od); od = MFMA32(pa1, v1, od); od = MFMA32(pa2, v2, od); od = MFMA32(pa3, v3, od);
#pragma unroll
      for (int r = 0; r < 16; ++r) OI[(size_t)(row0 + 32 * tb + crow(r, hi)) * 512 + h * 128 + 32 * vb + r32] = od[r]; }
#pragma unroll
    for (int e = 0; e < 2; ++e) { const int kb = 2 * (wid & 1) + e;
        bf16x8 k0, k1, k2, k3; vfrags<0>(kbase + kb * 512, k0, k1, k2, k3);
        f32x16 u;
#pragma unroll
        for (int r = 0; r < 16; ++r) u[r] = 0.f;
        u = MFMA32(v0, k0, u); u = MFMA32(v1, k1, u); u = MFMA32(v2, k2, u); u = MFMA32(v3, k3, u);
#pragma unroll
        for (int r = 0; r < 16; ++r) UT[((size_t)unit * 128 + 32 * vb + crow(r, hi)) * 128 + 32 * kb + r32] = (bf16)(cvtpk(u[r], 0.f) & 0xffffu); }
    __syncthreads();
}
DI void hgrn_h2(Frame& F) {
    bf16* UT = (bf16*)(F.ws + WS_UT); const float* DC = (const float*)(F.ws + WS_DC);
    for (int g = F.vcu * 512 + F.tid; g < 16 * 128 * 64; g += F.G * 512) {
        const int bh = g >> 13, rem = g & 8191, v = rem >> 6, kp = rem & 63;
        unsigned* base = (unsigned*)(UT + ((size_t)bh * 64 * 128 + v) * 128 + 2 * kp);
        const float* dc = DC + (size_t)bh * 64 * 128 + 2 * kp;
        float s0 = 0.f, s1 = 0.f;
        for (int c0 = 0; c0 < 64; c0 += 8) {
            unsigned u[8]; float d0[8], d1[8];
#pragma unroll
            for (int i = 0; i < 8; ++i) { u[i] = base[(size_t)(c0 + i) * 4096 * 2]; d0[i] = dc[(c0 + i) * 128]; d1[i] = dc[(c0 + i) * 128 + 1]; }
#pragma unroll
            for (int i = 0; i < 8; ++i) { base[(size_t)(c0 + i) * 4096 * 2] = pk2(s0, s1); s0 = d0[i] * s0 + bflo(u[i]); s1 = d1[i] * s1 + bfhi(u[i]); }
        }
    }
}
DI void hgrn_h3_unit(Frame& F, int unit, const float* gout) {
    using namespace att;
    const bf16* Z = (const bf16*)(F.ws + WS_Z); const bf16* QD = (const bf16*)(F.ws + WS_QD); const float* OI = (const float*)(F.ws + WS_OI); const bf16* ST = (const bf16*)(F.ws + WS_UT);
    bf16* OC = (bf16*)(F.ws + WS_XN);
    const int bh = unit >> 6, c = unit & 63, b = bh >> 2, h = bh & 3, row0 = b * SEQ + c * 64;
    unsigned char* lds = F.ldsg;
    char* SI = (char*)lds; char* QI = (char*)lds + 32768; float* PART = (float*)(lds + 49152);
    const int tid = F.tid, wid = F.wave, lane = F.lane, r32 = lane & 31, hi = lane >> 5;
#pragma unroll
    for (int i = 0; i < 4; ++i) { const int idx = tid + 512 * i, row = idx >> 4, c8 = idx & 15;
        *(v4u*)(SI + kswz<256>(row, c8 * 16)) = *(const v4u*)(ST + ((size_t)unit * 128 + row) * 128 + c8 * 8); }
#pragma unroll
    for (int i = 0; i < 2; ++i) { const int idx = tid + 512 * i, row = idx >> 4, c8 = idx & 15;
        *(v4u*)(QI + kswz<256>(row, c8 * 16)) = *(const v4u*)(QD + (size_t)(row0 + row) * 512 + h * 128 + c8 * 8); }
    __syncthreads();
    const int tb = wid & 1, vb = wid >> 1;
    f32x16 acc;
#pragma unroll
    for (int r = 0; r < 16; ++r) acc[r] = 0.f;
#pragma unroll
    for (int d0 = 0; d0 < 8; ++d0) { const int cb = (d0 * 16 + hi * 8) * 2;
        const bf16x8 a = *reinterpret_cast<const bf16x8*>(QI + kswz<256>(32 * tb + r32, cb));
        const bf16x8 bb = *reinterpret_cast<const bf16x8*>(SI + kswz<256>(32 * vb + r32, cb));
        acc = MFMA32(a, bb, acc); }
#pragma unroll
    for (int r = 0; r < 16; ++r) { const int trow = row0 + 32 * tb + crow(r, hi);
        acc[r] += OI[(size_t)trow * 512 + h * 128 + 32 * vb + r32];
        float s = acc[r] * acc[r];
        s += __shfl_xor(s, 1); s += __shfl_xor(s, 2); s += __shfl_xor(s, 4); s += __shfl_xor(s, 8); s += __shfl_xor(s, 16);
        if (r32 == 0) PART[(32 * tb + crow(r, hi)) * 4 + vb] = s; }
    __syncthreads();
    const float gv = gout[h * 128 + 32 * vb + r32];
#pragma unroll
    for (int r = 0; r < 16; ++r) { const int t = 32 * tb + crow(r, hi), trow = row0 + t;
        const f32x4 pp = *(const f32x4*)(PART + t * 4);
        const float rs = 1.f / sqrtf(((pp[0] + pp[1]) + (pp[2] + pp[3])) * (1.f / 128.f) + EPS);
        const float gt = bf2f(Z[(size_t)trow * ZE + 2304 + h * 128 + 32 * vb + r32]);
        const float sg = gt * __builtin_amdgcn_rcpf(1.f + fexp(-gt));
        OC[(size_t)trow * 1024 + 512 + h * 128 + 32 * vb + r32] = (bf16)(cvtpk(acc[r] * rs * gv * sg, 0.f) & 0xffffu); }
    __syncthreads();
}
DI void diff_combine(Frame& F, const float* lamp, const float* ghead, float linit) {
    const bf16* OD = (const bf16*)(F.ws + WS_Q); bf16* OC = (bf16*)(F.ws + WS_XN);
    const float sa = wave_sum(lamp[F.lane] * lamp[64 + F.lane]), sb = wave_sum(lamp[128 + F.lane] * lamp[192 + F.lane]);
    const float lam = fexp(sa) - fexp(sb) + linit, post = 1.f - linit;
    const int gw = F.vcu * NWAVES + F.wave, NGW = F.G * NWAVES;
    for (int m = gw; m < M; m += NGW) {
#pragma unroll
        for (int h = 0; h < 8; ++h) {
            const unsigned a = *(const unsigned*)(OD + (size_t)m * 2048 + (2 * h) * 128 + 2 * F.lane), bq = *(const unsigned*)(OD + (size_t)m * 2048 + (2 * h + 1) * 128 + 2 * F.lane);
            const float d0 = bflo(a) - lam * bflo(bq), d1 = bfhi(a) - lam * bfhi(bq);
            const float rs = post / sqrtf(wave_sum(d0 * d0 + d1 * d1) * (1.f / 128.f) + EPS);
            const float g0 = ghead[h * 128 + 2 * F.lane], g1 = ghead[h * 128 + 2 * F.lane + 1];
            *(unsigned*)(OC + (size_t)m * 1024 + h * 128 + 2 * F.lane) = pk2(d0 * rs * g0, d1 * rs * g1);
        }
    }
}

#ifndef PHASE_MASK
#define PHASE_MASK 0xFFFFF
#endif
#define EN(k) ((PHASE_MASK >> (k)) & 1)
#ifndef QKV_REP
#define QKV_REP 1
#endif
#ifndef H1_REP
#define H1_REP 1
#endif
#ifndef PROBE_A
#define PROBE_A -1
#define PROBE_B -1
#define PROBE_N 2
#endif
#ifndef MK_PER_PHASE
#define MK_PER_PHASE 0
#endif
constexpr int N_PHASES = 1 + 4 * 6 + 2 * 6 + 2 * 5;
__global__ void __launch_bounds__(NWAVES * 64, 2) fwd_kernel(Args args) {
    extern __shared__ __attribute__((aligned(16))) unsigned char lds[];
    Frame F;
    F.lds = (LAS unsigned char*)lds; F.ldsg = lds;
    F.MISC = (volatile LAS unsigned*)(F.lds + MISC_OFF);
    F.tid = threadIdx.x; F.lane = F.tid & 63; F.wave = __builtin_amdgcn_readfirstlane(F.tid >> 6);
    F.G = gridDim.x; { const int bx = blockIdx.x; F.vcu = (F.G % 8 == 0) ? (bx % 8) * (F.G / 8) + bx / 8 : bx; }
    KA const Args* A = (KA const Args*)__builtin_amdgcn_kernarg_segment_ptr();
    F.ws = A->ws; F.ctl = (gu32*)(A->ws + WS_CTL);
    for (int u = F.tid; u < (LDS_BYTES - LDSCTL_OFF) / 4; u += NWAVES * 64) ((LAS unsigned*)(F.lds + LDSCTL_OFF))[u] = 0u;
    __syncthreads();
    const int lo = A->ph_lo, hi = A->ph_hi;
    XcdBarrier bar; bar.bar = (unsigned*)(F.ctl + CW_BAR); bar.x = 0; bar.st = nullptr;
    if (hi - lo > 1) bar = xcd_barrier_post((unsigned*)(F.ctl + CW_BAR) + A->li * XCD_BAR_WORDS, F.MISC + 8);
    int ph = 0;
#define PH_ON (ph >= lo && ph < hi)
#define PH_END do { if (ph >= lo && ph + 1 < hi) xcd_barrier(bar); ++ph; } while (0)

#define x_in ((const float*)A->in[0])
#define norm_g ((const float*)A->in[2])
#define X (A->out)
#define XN ((bf16*)(F.ws + WS_XN))
#define Y ((bf16*)(F.ws + WS_Y))
#define Zb ((bf16*)(F.ws + WS_Z))
#define W (F.ws + WS_W)
#define LAUNDER do { KA const Args* ap_ = (KA const Args*)__builtin_amdgcn_kernarg_segment_ptr(); asm volatile("" : "+s"(ap_)); A = ap_; unsigned char* w_ = ap_->ws; asm volatile("" : "+s"(w_)); F.ws = w_; int t_ = threadIdx.x; asm volatile("" : "+v"(t_)); F.tid = t_; F.lane = t_ & 63; F.wave = __builtin_amdgcn_readfirstlane(t_ >> 6); int g_ = gridDim.x, b_ = blockIdx.x; asm volatile("" : "+s"(g_), "+s"(b_)); F.G = g_; F.bx = b_; F.vcu = (g_ % 8 == 0) ? (b_ % 8) * (g_ / 8) + b_ / 8 : b_; } while (0)
    constexpr float LOG2E = 1.4426950408889634f;

    if (PH_ON && EN(0)) { LAUNDER; build_tables(F, A); convert_layer(F, A, 0); thin_rows(F, x_in, nullptr, nullptr, nullptr, 0.f, norm_g, XN); }
    PH_END;

    for (int l = 0; l < DEPTH; ++l) {
        #define g_l (norm_g + (size_t)l * 6 * D)
        for (int half = 0; half < 2; ++half) {
            if (PH_ON && EN(1)) { LAUNDER;
                pg8::Gemm g{XN, (const bf16*)(W + (half ? W_GU1 : W_GU0)), M, 2 * FF, D, D, D}; pg8::StaticOrder S; S.init(M, 2 * FF, F.G, F.bx);
                pg8::EpiSwiglu E{Zb, FF};
                pg8::gemm_phase<pg8::EpiSwiglu, pg8::StaticOrder, true, true>(F.lds + RING_OFF, g, S, E);
            }
            PH_END;
            if (PH_ON && EN(2)) { LAUNDER;
                pg8::Gemm g{Zb, (const bf16*)(W + (half ? W_D1 : W_D0)), M, D, FF, FF, FF}; pg8::StaticOrder S; S.init(M, D, F.G, F.bx);
                pg8::EpiPlain E{Y, D};
                pg8::gemm_phase<pg8::EpiPlain, pg8::StaticOrder, true, true>(F.lds + RING_OFF, g, S, E);
            }
            PH_END;
            if (PH_ON && EN(3)) { LAUNDER;
                const float* xin = (l == 0 && half == 0) ? x_in : X;
                const float* gpost = g_l + (half ? 5 : 1) * D;
                const float* gpre = half == 0 ? g_l + 2 * D : (l + 1 < DEPTH ? norm_g + (size_t)(l + 1) * 6 * D : nullptr);
                thin_rows(F, xin, X, Y, gpost, 0.5f, gpre, XN);
                if (half == 1 && l + 1 < DEPTH) convert_layer(F, A, l + 1);
            }
            PH_END;
            if (half == 0) {
                const int j = l >> 1;
                if ((l & 1) == 0) {
                    if (PH_ON && EN(4)) { LAUNDER;
                        pg8::Gemm g{XN, (const bf16*)(W + W_EIN), M, ZE, D, D, D}; pg8::StaticOrder S; S.init(M, ZE, F.G, F.bx);
                        pg8::EpiZEven E{Zb, (float*)(F.ws + WS_SP), (bf16*)(F.ws + WS_K), (const float*)(F.ws + WS_TM)};
                        pg8::gemm_phase<pg8::EpiZEven, pg8::StaticOrder, true, true>(F.lds + RING_OFF, g, S, E);
                    }
                    PH_END;
                    if (PH_ON && EN(5)) { LAUNDER;
                        LAS float* RS = (LAS float*)(F.lds + RS_OFF); LAS int* RSPM = (LAS int*)(F.lds + RS_OFF + 4096);
                        for (int rq_ = 0; rq_ < QKV_REP; ++rq_) {
                        if (EN(14)) { pg8::Gemm g{Zb, (const bf16*)(W + W_EUQ), M, 768, 384, ZE, 384}; pg8::StaticOrder S; S.init(M, 768, F.G, F.bx);
                          fill_rs(F, S, (const float*)(F.ws + WS_SP), 0, 3, 1.0f / 384.0f, 0.07216878364870322f * LOG2E, RS, RSPM);
                          pg8::EpiQ E{(bf16*)(F.ws + WS_Q), RS, RSPM, (const float*)(F.ws + WS_TM)};
                          pg8::gemm_phase<pg8::EpiQ, pg8::StaticOrder, true, true>(F.lds + RING_OFF, g, S, E); }
                        __syncthreads();
                        LAUNDER;
                        if (EN(15)) { pg8::Gemm g{Zb + 384, (const bf16*)(W + W_EUKV), M, 1024, 256, ZE, 256}; pg8::StaticOrder S; S.init(M, 1024, F.G, F.bx);
                          fill_rs(F, S, (const float*)(F.ws + WS_SP), 12, 2, 1.0f / 256.0f, 1.0f, RS, RSPM);
                          pg8::EpiKV E{(bf16*)(F.ws + WS_K), (bf16*)(F.ws + WS_V), RS, RSPM};
                          pg8::gemm_phase<pg8::EpiKV, pg8::StaticOrder, true, true>(F.lds + RING_OFF, g, S, E); }
                        __syncthreads();
                        }
                        LAUNDER;
                        if (EN(16)) for (int rep_ = 0; rep_ < H1_REP; ++rep_) for (int u = F.vcu; u < 1024; u += F.G) hgrn_h1_unit(F, u, j);
                    }
                    PH_END;
                    if (PH_ON && EN(6)) { LAUNDER;
                        if (EN(17)) hgrn_h2(F);
                        LAUNDER;
                        if (EN(18))
                        for (int u = F.vcu; u < 256; u += F.G) {
                            const int st = u >> 4, qb = 15 - (u & 15), b = st >> 2, h = st & 3;
                            att::attn_unit<192>((const bf16*)(F.ws + WS_Q) + (size_t)b * SEQ * 768 + h * 192, 768, (const bf16*)(F.ws + WS_K) + (size_t)b * SEQ * 768 + h * 192, 768,
                                                (const bf16*)(F.ws + WS_V) + (size_t)b * SEQ * 512 + h * 128, 512, XN + (size_t)b * SEQ * 1024 + h * 128, 1024, qb * 256, (char*)F.ldsg);
                        }
                    }
                    PH_END;
                    if (PH_ON && EN(7)) { LAUNDER; const float* gout = (const float*)A->in[12] + j * 512; for (int u = F.vcu; u < 1024; u += F.G) hgrn_h3_unit(F, u, gout); }
                    PH_END;
                    if (PH_ON && EN(8)) { LAUNDER;
                        pg8::Gemm g{XN, (const bf16*)(W + W_EOUT), M, D, D, D, D}; pg8::StaticOrder S; S.init(M, D, F.G, F.bx);
                        pg8::EpiPlain E{Y, D};
                        pg8::gemm_phase<pg8::EpiPlain, pg8::StaticOrder, true, true>(F.lds + RING_OFF, g, S, E);
                    }
                    PH_END;
                } else {
                    if (PH_ON && EN(9)) { LAUNDER;
                        pg8::Gemm g{XN, (const bf16*)(W + W_OIN), M, ZO, D, D, D}; pg8::StaticOrder S; S.init(M, ZO, F.G, F.bx);
                        pg8::EpiZOdd E{Zb, (const float*)(F.ws + WS_TD), 0.125f * LOG2E};
                        pg8::gemm_phase<pg8::EpiZOdd, pg8::StaticOrder, true, true>(F.lds + RING_OFF, g, S, E);
                    }
                    PH_END;
                    if (PH_ON && EN(10)) { LAUNDER;
                        for (int c = F.vcu; c < 256; c += F.G) {
                            const int st = c >> 2, gq = c & 3, b = st >> 4, hc = st & 15, h = hc >> 1;
#pragma unroll 1
                            for (int k = 0; k < 4; ++k) {
                                const int qb = (k == 0) ? 15 - gq : (k == 1) ? 8 + gq : (k == 2) ? 7 - gq : gq;
                                att::attn_unit<64>(Zb + (size_t)b * SEQ * ZO + hc * 64, ZO, Zb + (size_t)b * SEQ * ZO + 1024 + hc * 64, ZO, Zb + (size_t)b * SEQ * ZO + 2048 + h * 128, ZO,
                                                   (bf16*)(F.ws + WS_Q) + (size_t)b * SEQ * 2048 + hc * 128, 2048, qb * 256, (char*)F.ldsg);
                            }
                        }
                    }
                    PH_END;
                    if (PH_ON && EN(11)) { LAUNDER; const float linit = A->linit[j]; diff_combine(F, (const float*)A->in[15] + j * 256, (const float*)A->in[16] + j * 1024, linit); }
                    PH_END;
                    if (PH_ON && EN(12)) { LAUNDER;
                        pg8::Gemm g{XN, (const bf16*)(W + W_OOUT), M, D, D, D, D}; pg8::StaticOrder S; S.init(M, D, F.G, F.bx);
                        pg8::EpiPlain E{Y, D};
                        pg8::gemm_phase<pg8::EpiPlain, pg8::StaticOrder, true, true>(F.lds + RING_OFF, g, S, E);
                    }
                    PH_END;
                }
                if (PH_ON && EN(13)) { LAUNDER; thin_rows(F, X, X, Y, g_l + 3 * D, 1.0f, g_l + 4 * D, XN); }
                PH_END;
            }
        }
    }
#undef PH_ON
#undef PH_END
#undef XN
#undef Y
#undef Zb
#undef W
#undef LAUNDER
#undef x_in
#undef norm_g
#undef X
#undef g_l
}

extern "C" void kernel_launch(void* const* d_in, const int* in_sizes, int n_in, void* d_out, int out_size, void* d_ws, size_t ws_size, hipStream_t stream) {
    static int grid = 0;
    if (grid == 0) {
        if (n_in != 18 || in_sizes[0] != M * D || out_size != M * D || ws_size < WS_END) { fprintf(stderr, "kernel_launch: unexpected shapes (n_in %d, in0 %d, out %d, ws %zu)\n", n_in, n_in > 0 ? in_sizes[0] : -1, out_size, ws_size); grid = -1; return; }
        int dev = 0, cus = 0, per_cu = 0;
        if (hipGetDevice(&dev) != hipSuccess || hipDeviceGetAttribute(&cus, hipDeviceAttributeMultiprocessorCount, dev) != hipSuccess) { grid = -1; return; }
        if (hipFuncSetAttribute((const void*)fwd_kernel, hipFuncAttributeMaxDynamicSharedMemorySize, LDS_BYTES) != hipSuccess) { fprintf(stderr, "kernel_launch: hipFuncSetAttribute failed\n"); grid = -1; return; }
        if (hipOccupancyMaxActiveBlocksPerMultiprocessor(&per_cu, (const void*)fwd_kernel, NWAVES * 64, LDS_BYTES) != hipSuccess || per_cu < 1)
            fprintf(stderr, "kernel_launch: note: occupancy query reports %d workgroups per CU\n", per_cu);
        (void)hipGetLastError();
        grid = cus;
    }
    if (grid < 0) return;
    if (hipMemsetAsync((char*)d_ws + WS_CTL, 0, CTL_ZERO_BYTES, stream) != hipSuccess) return;
    Args a{};
    for (int i = 0; i < 18; ++i) a.in[i] = d_in[i];
    a.out = (float*)d_out; a.ws = (unsigned char*)d_ws;
    for (int i = 0; i < 32; ++i) a.invf_m[i] = (float)pow(500000.0, -(double)(2 * i) / 64.0);
    for (int i = 0; i < 8; ++i) a.invf_d[i] = (float)pow(500000.0, -(double)(2 * i) / 16.0);
    for (int jj = 0; jj < 2; ++jj) a.linit[jj] = (float)(0.8 - 0.6 * exp(-0.3 * (double)(2 * jj + 1)));
#if MK_PER_PHASE
    for (int p = 0; p < N_PHASES; ++p) { a.ph_lo = p; a.ph_hi = p + 1; a.li = 0; hipLaunchKernelGGL(fwd_kernel, dim3(grid), dim3(NWAVES * 64), LDS_BYTES, stream, a); }
#else
    if (PROBE_A >= 0) {
        a.ph_lo = 0; a.ph_hi = PROBE_B + 1; a.li = 0; hipLaunchKernelGGL(fwd_kernel, dim3(grid), dim3(NWAVES * 64), LDS_BYTES, stream, a);
        for (int r = 1; r < PROBE_N; ++r) { a.ph_lo = PROBE_A; a.ph_hi = PROBE_B + 1; a.li = r; hipLaunchKernelGGL(fwd_kernel, dim3(grid), dim3(NWAVES * 64), LDS_BYTES, stream, a); }
        a.ph_lo = PROBE_A; a.ph_hi = N_PHASES; a.li = PROBE_N; hipLaunchKernelGGL(fwd_kernel, dim3(grid), dim3(NWAVES * 64), LDS_BYTES, stream, a);
    } else {
        a.ph_lo = 0; a.ph_hi = N_PHASES; a.li = 0;
        hipLaunchKernelGGL(fwd_kernel, dim3(grid), dim3(NWAVES * 64), LDS_BYTES, stream, a);
    }
#endif
    const hipError_t le = hipPeekAtLastError();
    if (le != hipSuccess) fprintf(stderr, "kernel_launch: launch failed: %s\n", hipGetErrorName(le));
}
```

```cpp
#include <hip/hip_runtime.h>
#include <cstdio>
#include <cstdint>
#include <cmath>
namespace pg8 {
#define PG8_LAS __attribute__((address_space(3)))
typedef unsigned short bf16_t;
typedef short bf16x8 __attribute__((ext_vector_type(8)));
typedef float f32x4 __attribute__((ext_vector_type(4)));
typedef unsigned u32x4 __attribute__((ext_vector_type(4)));
constexpr int BM = 256, BK = 64, HALF = 128, HTB = HALF * BK * 2  , STAGE_BYTES = 8 * HTB, NXCD = 8, WGM = 8;

__host__ __device__ __forceinline__ int lds_byte(int r, int c) { const int st = (r >> 4) * 2 + (c >> 5), rr = r & 15, cc = c & 31, ob = rr * 64 + cc * 2; return st * 1024 + (ob ^ (((ob >> 9) & 1) << 5)); }
__host__ __device__ __forceinline__ void stage_rc(int b, int& R, int& C) { const int st = b / 1024, sb = b % 1024, swz = sb ^ (((sb >> 9) & 1) << 5); R = (st >> 1) * 16 + swz / 64; C = (st & 1) * 32 + (swz % 64) / 2; }
__host__ __device__ __forceinline__ int perm32(int rho) { const int n = rho >> 4, i = rho & 15; return 8 * (i >> 2) + 4 * n + (i & 3); }

struct Unit { int pm, pn; };
struct Gemm { const bf16_t* A; const bf16_t* Bt; int M, N, K, lda, ldb; };

struct StaticOrder {
    int nM, nN, nwg, G, c;
    __host__ __device__ void init(int M, int N, int G_, int c_) { nM = M / BM; nN = N / BM; nwg = nM * nN; G = G_; c = c_; }
    __host__ __device__ bool next(int i, Unit& u) const {
        const long L = (long)i * G + c; if (L >= nwg) return false;
        int wgid = (int)L; { const int q = nwg / NXCD, r = nwg % NXCD, xcd = wgid % NXCD, off = wgid / NXCD; wgid = (xcd < r ? xcd * (q + 1) : r * (q + 1) + (xcd - r) * q) + off; }
        const int nig = WGM * nN, gid = wgid / nig, fm = gid * WGM, gsz = (nM - fm) < WGM ? (nM - fm) : WGM;
        u.pm = fm + ((wgid % nig) % gsz); u.pn = (wgid % nig) / gsz; return true;
    }
    __device__ __forceinline__ void a_ready(const Unit&) const {}
    __device__ __forceinline__ void done(const Unit&) const {}
};

typedef float f32x2_t_ __attribute__((ext_vector_type(2))); typedef __bf16 bf16x2_t_ __attribute__((ext_vector_type(2)));
__device__ __forceinline__ unsigned cvt_pk_bf16(float lo, float hi) { f32x2_t_ v = {lo, hi}; bf16x2_t_ b = __builtin_convertvector(v, bf16x2_t_); return __builtin_bit_cast(unsigned, b); }
typedef float f32x2 __attribute__((ext_vector_type(2)));
__device__ __forceinline__ float fast_exp(float x) { return __builtin_amdgcn_exp2f(x * 1.4426950408889634f); }
__device__ __forceinline__ float silu_f(float g) { return g * __builtin_amdgcn_rcpf(1.f + __builtin_amdgcn_exp2f(-1.4426950408889634f * g)); }
__device__ __forceinline__ u32x4 pack8(const f32x4 a, const f32x4 b) { u32x4 w; w.x = cvt_pk_bf16(a[0], a[1]); w.y = cvt_pk_bf16(a[2], a[3]); w.z = cvt_pk_bf16(b[0], b[1]); w.w = cvt_pk_bf16(b[2], b[3]); return w; }

#define EPI_IDS int t_ = threadIdx.x; asm volatile("" : "+v"(t_)); const int wid_ = __builtin_amdgcn_readfirstlane(t_ >> 6), wr = wid_ >> 2, wc = wid_ & 3, fr = t_ & 15, fq = (t_ & 63) >> 4; (void)wr_; (void)wc_; (void)fr_; (void)fq_
struct EpiPlain {
    static constexpr bool PERM = true, AFTER_DRAIN = false;
    bf16_t* O; int ldc;
    __device__ __forceinline__ void operator()(const f32x4 (&acc)[2][2][4][2], const Unit& u, int wr_, int wc_, int fr_, int fq_) const {
        EPI_IDS;
        const int row0 = u.pm * BM + wr * 64 + fr, col0 = u.pn * BM + wc * 32 + 8 * fq;
#pragma unroll
        for (int ai = 0; ai < 2; ++ai)
#pragma unroll
            for (int m = 0; m < 4; ++m) { bf16_t* rowp = O + (size_t)(row0 + ai * HALF + m * 16) * ldc + col0;
#pragma unroll
                for (int bj = 0; bj < 2; ++bj) *(u32x4*)(rowp + bj * HALF) = pack8(acc[ai][bj][m][0], acc[ai][bj][m][1]); }
    }
};
struct EpiSwiglu {
    static constexpr bool PERM = true, AFTER_DRAIN = false;
    bf16_t* H; int ldh;
    __device__ __forceinline__ void operator()(const f32x4 (&acc)[2][2][4][2], const Unit& u, int wr_, int wc_, int fr_, int fq_) const {
        EPI_IDS;
        const int row0 = u.pm * BM + wr * 64 + fr, col0 = u.pn * HALF + wc * 32 + 8 * fq;
#pragma unroll
        for (int ai = 0; ai < 2; ++ai)
#pragma unroll
            for (int m = 0; m < 4; ++m) {
                f32x4 h0, h1;
#pragma unroll
                for (int i = 0; i < 4; ++i) { h0[i] = silu_f(acc[ai][0][m][0][i]) * acc[ai][1][m][0][i]; h1[i] = silu_f(acc[ai][0][m][1][i]) * acc[ai][1][m][1][i]; }
                *(u32x4*)(H + (size_t)(row0 + ai * HALF + m * 16) * ldh + col0) = pack8(h0, h1);
            }
    }
};
struct EpiZEven {
    static constexpr bool PERM = true, AFTER_DRAIN = false;
    bf16_t* Z; float* SP; bf16_t* Kb; const float* TM;
    __device__ __forceinline__ void operator()(const f32x4 (&acc)[2][2][4][2], const Unit& u, int wr_, int wc_, int fr_, int fq_) const {
        EPI_IDS;
        const int row0 = u.pm * BM + wr * 64 + fr, col0 = u.pn * BM + wc * 32 + 8 * fq;
#pragma unroll
        for (int ai = 0; ai < 2; ++ai)
#pragma unroll
            for (int m = 0; m < 4; ++m) {
                const int row = row0 + ai * HALF + m * 16;
#pragma unroll
                for (int bj = 0; bj < 2; ++bj) {
                    const f32x4 v0 = acc[ai][bj][m][0], v1 = acc[ai][bj][m][1];
                    *(u32x4*)(Z + (size_t)row * 2816 + col0 + bj * HALF) = pack8(v0, v1);
                    int slot = -1;
                    if (u.pn == 0) slot = bj * 4 + wc; else if (u.pn == 1) slot = (bj == 0 ? 8 : 12) + wc; else if (u.pn == 2 && bj == 0) slot = 16 + wc;
                    if (slot >= 0) {
                        float s = (v0[0] * v0[0] + v0[1] * v0[1]) + (v0[2] * v0[2] + v0[3] * v0[3]) + (v1[0] * v1[0] + v1[1] * v1[1]) + (v1[2] * v1[2] + v1[3] * v1[3]);
                        s += __shfl_xor(s, 16); s += __shfl_xor(s, 32);
                        if (fq == 0) SP[(size_t)row * 20 + slot] = s;
                    }
                    if (u.pn == 2 && bj == 1 && wc < 2) {
                        const int j = 4 * wc + fq;
                        const f32x4 c = *(const f32x4*)(TM + (size_t)row * 64 + 4 * j), s = *(const f32x4*)(TM + (size_t)row * 64 + 32 + 4 * j);
                        const f32x4 o1 = v0 * c - v1 * s, o2 = v1 * c + v0 * s;
                        const u32x4 w = pack8(o1, o2);
#pragma unroll
                        for (int h = 0; h < 4; ++h) *(u32x4*)(Kb + (size_t)row * 768 + h * 192 + 128 + 8 * j) = w;
                    }
                }
            }
    }
};
struct EpiQ {
    static constexpr bool PERM = true, AFTER_DRAIN = false;
    bf16_t* Q; const PG8_LAS float* RS; const PG8_LAS int* RSPM; const float* TM;
    __device__ __forceinline__ void operator()(const f32x4 (&acc)[2][2][4][2], const Unit& u, int wr_, int wc_, int fr_, int fq_) const {
        EPI_IDS;
        int slot = 0;
#pragma unroll
        for (int s = 1; s < 4; ++s) if (RSPM[s] == u.pm) slot = s;
        const int rl0 = wr * 64 + fr, row0 = u.pm * BM + rl0;
#pragma unroll
        for (int ai = 0; ai < 2; ++ai)
#pragma unroll
            for (int m = 0; m < 4; ++m) {
                const int row = row0 + ai * HALF + m * 16;
                const float rs = RS[slot * 256 + rl0 + ai * HALF + m * 16];
#pragma unroll
                for (int bj = 0; bj < 2; ++bj) {
                    const f32x4 v0 = acc[ai][bj][m][0] * rs, v1 = acc[ai][bj][m][1] * rs;
                    if (u.pn < 2) {
                        const int head = 2 * u.pn + bj;
                        *(u32x4*)(Q + (size_t)row * 768 + head * 192 + wc * 32 + 8 * fq) = pack8(v0, v1);
                    } else {
                        const int head = 2 * bj + (wc >> 1), j = 4 * (wc & 1) + fq;
                        const f32x4 cs = *(const f32x4*)(TM + (size_t)row * 64 + 4 * j), sn = *(const f32x4*)(TM + (size_t)row * 64 + 32 + 4 * j);
                        const f32x4 o1 = v0 * cs - v1 * sn, o2 = v1 * cs + v0 * sn;
                        *(u32x4*)(Q + (size_t)row * 768 + head * 192 + 128 + 8 * j) = pack8(o1, o2);
                    }
                }
            }
    }
};
struct EpiKV {
    static constexpr bool PERM = true, AFTER_DRAIN = false;
    bf16_t* Kb; bf16_t* Vb; const PG8_LAS float* RS; const PG8_LAS int* RSPM;
    __device__ __forceinline__ void operator()(const f32x4 (&acc)[2][2][4][2], const Unit& u, int wr_, int wc_, int fr_, int fq_) const {
        EPI_IDS;
        int slot = 0;
#pragma unroll
        for (int s = 1; s < 4; ++s) if (RSPM[s] == u.pm) slot = s;
        const int rl0 = wr * 64 + fr, row0 = u.pm * BM + rl0;
#pragma unroll
        for (int ai = 0; ai < 2; ++ai)
#pragma unroll
            for (int m = 0; m < 4; ++m) {
                const int row = row0 + ai * HALF + m * 16;
                const float rs = RS[slot * 256 + rl0 + ai * HALF + m * 16];
                *(u32x4*)(Kb + (size_t)row * 768 + u.pn * 192 + wc * 32 + 8 * fq) = pack8(acc[ai][0][m][0] * rs, acc[ai][0][m][1] * rs);
                *(u32x4*)(Vb + (size_t)row * 512 + u.pn * 128 + wc * 32 + 8 * fq) = pack8(acc[ai][1][m][0] * rs, acc[ai][1][m][1] * rs);
            }
    }
};
struct EpiZOdd {
    static constexpr bool PERM = true, AFTER_DRAIN = false;
    bf16_t* Z; const float* TD; float qscale;
    __device__ __forceinline__ void operator()(const f32x4 (&acc)[2][2][4][2], const Unit& u, int wr_, int wc_, int fr_, int fq_) const {
        EPI_IDS;
        const int row0 = u.pm * BM + wr * 64 + fr, col0 = u.pn * BM + wc * 32 + 8 * fq;
        const bool rot = (u.pn < 8) && ((wc & 1) == 0) && (fq < 2);
        const float sc = (u.pn < 4) ? qscale : 1.0f;
#pragma unroll
        for (int ai = 0; ai < 2; ++ai)
#pragma unroll
            for (int m = 0; m < 4; ++m) {
                const int row = row0 + ai * HALF + m * 16;
                f32x4 cs = {1.f, 1.f, 1.f, 1.f}, sn = {0.f, 0.f, 0.f, 0.f};
                if (rot) { cs = *(const f32x4*)(TD + (size_t)row * 16 + 4 * fq); sn = *(const f32x4*)(TD + (size_t)row * 16 + 8 + 4 * fq); }
#pragma unroll
                for (int bj = 0; bj < 2; ++bj) {
                    const f32x4 v0 = acc[ai][bj][m][0] * sc, v1 = acc[ai][bj][m][1] * sc;
                    const f32x4 o1 = rot ? (v0 * cs - v1 * sn) : v0, o2 = rot ? (v1 * cs + v0 * sn) : v1;
                    *(u32x4*)(Z + (size_t)row * 3072 + col0 + bj * HALF) = pack8(o1, o2);
                }
            }
    }
};

template <class Epi, class Sched, bool ALIGN_EPI = false, bool SP2 = false>
__device__ __forceinline__ void gemm_phase(PG8_LAS unsigned char* lds, const Gemm g, const Sched& S, const Epi& E) {
    int tid_ = threadIdx.x; asm volatile("" : "+v"(tid_)); const int tid = tid_, wid = __builtin_amdgcn_readfirstlane(tid >> 6), lane = tid & 63, wr = wid >> 2, wc = wid & 3, fr = lane & 15, fq = lane >> 4;
    int K_ = g.K; asm volatile("" : "+s"(K_)); const int K = K_, nt = K / BK;
    unsigned voffA[2], voffB[2];
#pragma unroll
    for (int i = 0; i < 2; ++i) { int R, C; stage_rc(tid * 16 + i * 8192, R, C); const int Rb = Epi::PERM ? ((R & ~31) + perm32(R & 31)) : R;
        voffA[i] = (unsigned)(R * g.lda + C) * 2u; voffB[i] = (unsigned)(Rb * g.ldb + C) * 2u; }
    const size_t kstep = (size_t)(BK * 2);
    const size_t hA = (size_t)HALF * g.lda * 2, hB = (size_t)HALF * g.ldb * 2;
    const size_t tA = 2 * hA, tB = 2 * hB;
    const unsigned ldsw = (unsigned)wid * 1024u;
    const int aoff = lds_byte(wr * 64 + fr, fq * 8), boff = lds_byte(wc * 32 + fr, fq * 8);
#define PG8_SA(b, h) (((b) * 2 + (h)) * HTB)
#define PG8_SB(b, h) ((4 + (b) * 2 + (h)) * HTB)
#define PG8_STAGE(bufoff, gbase, voff) do { _Pragma("unroll") for (int _i = 0; _i < 2; ++_i) \
        __builtin_amdgcn_global_load_lds((const unsigned*)((const char*)(gbase) + (voff)[_i]), (PG8_LAS unsigned*)(lds + (bufoff) + ldsw + _i * 8192), 16, 0, 0); } while (0)
#define PG8_LDA(dst, b, h) do { _Pragma("unroll") for (int m = 0; m < 4; ++m) _Pragma("unroll") for (int k = 0; k < 2; ++k) dst[m][k] = *(const PG8_LAS bf16x8*)(lds + PG8_SA(b, h) + aoff + m * 2048 + k * 1024); } while (0)
#define PG8_LDB(dst, b, h) do { _Pragma("unroll") for (int n = 0; n < 2; ++n) _Pragma("unroll") for (int k = 0; k < 2; ++k) dst[n][k] = *(const PG8_LAS bf16x8*)(lds + PG8_SB(b, h) + boff + n * 2048 + k * 1024); } while (0)
#define PG8_MMA(ai, bj, At, Bt) do { __builtin_amdgcn_s_setprio(1); _Pragma("unroll") for (int m = 0; m < 4; ++m) _Pragma("unroll") for (int n = 0; n < 2; ++n) _Pragma("unroll") for (int k = 0; k < 2; ++k) \
        acc[ai][bj][m][n] = __builtin_amdgcn_mfma_f32_16x16x32_bf16(Bt[n][k], At[m][k], acc[ai][bj][m][n], 0, 0, 0); __builtin_amdgcn_s_setprio(0); } while (0)
#define PG8_WAIT_V(n) asm volatile("s_waitcnt vmcnt(" #n ")" ::: "memory")
#define PG8_WAIT_L(n) asm volatile("s_waitcnt lgkmcnt(" #n ")" ::: "memory")
#define PG8_BAR __builtin_amdgcn_s_barrier()
#define PG8_SCHED __builtin_amdgcn_sched_barrier(0)
    Unit cur, nxt; int ui = 0;
    if (!S.next(0, cur)) return;
    f32x4 acc[2][2][4][2];
#pragma unroll
    for (int a = 0; a < 2; ++a)
#pragma unroll
        for (int b = 0; b < 2; ++b)
#pragma unroll
            for (int m = 0; m < 4; ++m)
#pragma unroll
                for (int n = 0; n < 2; ++n) acc[a][b][m][n] = (f32x4){0.f, 0.f, 0.f, 0.f};
    bf16x8 At[4][2], B0[2][2], B1[2][2];
    const char* cA = (const char*)g.A + (size_t)cur.pm * tA; const char* cB = (const char*)g.Bt + (size_t)cur.pn * tB;
    S.a_ready(cur);
    if constexpr (SP2) {
        PG8_STAGE(PG8_SB(0, 0), cB, voffB); PG8_STAGE(PG8_SB(0, 1), cB + hB, voffB); PG8_STAGE(PG8_SA(0, 0), cA, voffA); PG8_STAGE(PG8_SA(0, 1), cA + hA, voffA);
        if (wr == 1) PG8_BAR;
        PG8_WAIT_V(2); PG8_BAR;
        PG8_STAGE(PG8_SB(1, 0), cB + kstep, voffB); PG8_STAGE(PG8_SA(1, 0), cA + kstep, voffA); PG8_STAGE(PG8_SB(1, 1), cB + hB + kstep, voffB);
        PG8_WAIT_V(6); PG8_BAR;
    } else {
        PG8_STAGE(PG8_SB(0, 0), cB, voffB); PG8_STAGE(PG8_SA(0, 0), cA, voffA); PG8_STAGE(PG8_SB(0, 1), cB + hB, voffB); PG8_STAGE(PG8_SA(0, 1), cA + hA, voffA);
        if (wr == 1) PG8_BAR;
        PG8_WAIT_V(4); PG8_BAR;
        PG8_STAGE(PG8_SB(1, 0), cB + kstep, voffB); PG8_STAGE(PG8_SA(1, 0), cA + kstep, voffA); PG8_STAGE(PG8_SB(1, 1), cB + hB + kstep, voffB);
        PG8_WAIT_V(6); PG8_BAR;
    }
    for (;;) {
        const bool has_next = S.next(ui + 1, nxt);
        const char* nA = has_next ? (const char*)g.A + (size_t)nxt.pm * tA : cA; const char* nB = has_next ? (const char*)g.Bt + (size_t)nxt.pn * tB : cB;
#pragma unroll 1
        for (int t = 0; t < nt; t += 2) {
            const bool last = (t == nt - 2);
            const char* a1 = cA + (size_t)(t + 1) * kstep;
            const char* a2 = last ? nA : cA + (size_t)(t + 2) * kstep; const char* b2 = last ? nB : cB + (size_t)(t + 2) * kstep;
            const char* a3 = a2 + kstep; const char* b3 = b2 + kstep;
            if (last && has_next) S.a_ready(nxt);
            if constexpr (SP2) {
            PG8_LDB(B0, 0, 0); PG8_LDB(B1, 0, 1); PG8_SCHED; PG8_LDA(At, 0, 0); PG8_STAGE(PG8_SA(1, 1), a1 + hA, voffA);
            PG8_WAIT_V(8); PG8_WAIT_L(0); PG8_BAR; PG8_MMA(0, 0, At, B0); PG8_MMA(0, 1, At, B1); PG8_BAR; PG8_SCHED;
            PG8_LDA(At, 0, 1); PG8_STAGE(PG8_SB(0, 0), b2, voffB); PG8_STAGE(PG8_SB(0, 1), b2 + hB, voffB); PG8_STAGE(PG8_SA(0, 0), a2, voffA);
            PG8_WAIT_V(8); PG8_WAIT_L(0); PG8_BAR; PG8_MMA(1, 0, At, B0); PG8_MMA(1, 1, At, B1); PG8_BAR; PG8_SCHED;
            PG8_LDB(B0, 1, 0); PG8_LDB(B1, 1, 1); PG8_SCHED; PG8_LDA(At, 1, 0); PG8_STAGE(PG8_SA(0, 1), a2 + hA, voffA);
            PG8_WAIT_V(8); PG8_WAIT_L(0); PG8_BAR; PG8_MMA(0, 0, At, B0); PG8_MMA(0, 1, At, B1); PG8_BAR; PG8_SCHED;
            PG8_LDA(At, 1, 1); PG8_STAGE(PG8_SB(1, 0), b3, voffB); PG8_STAGE(PG8_SB(1, 1), b3 + hB, voffB); PG8_STAGE(PG8_SA(1, 0), a3, voffA);
            PG8_WAIT_V(8); PG8_WAIT_L(0); PG8_BAR; PG8_MMA(1, 0, At, B0); PG8_MMA(1, 1, At, B1); PG8_BAR; PG8_SCHED;
            } else {
            PG8_LDB(B0, 0, 0); PG8_SCHED; PG8_LDA(At, 0, 0); PG8_STAGE(PG8_SA(1, 1), a1 + hA, voffA);
            PG8_WAIT_L(8); PG8_BAR; PG8_WAIT_L(0); PG8_MMA(0, 0, At, B0); PG8_BAR; PG8_SCHED;
            PG8_LDB(B1, 0, 1); PG8_STAGE(PG8_SB(0, 0), b2, voffB);
            PG8_BAR; PG8_WAIT_L(0); PG8_MMA(0, 1, At, B1); PG8_BAR;
            PG8_LDA(At, 0, 1); PG8_STAGE(PG8_SA(0, 0), a2, voffA);
            PG8_BAR; PG8_WAIT_L(0); PG8_MMA(1, 0, At, B0); PG8_BAR; PG8_SCHED;
            PG8_STAGE(PG8_SB(0, 1), b2 + hB, voffB);
            PG8_WAIT_V(6); PG8_BAR; PG8_MMA(1, 1, At, B1); PG8_BAR;
            PG8_LDB(B0, 1, 0); PG8_SCHED; PG8_LDA(At, 1, 0); PG8_STAGE(PG8_SA(0, 1), a2 + hA, voffA);
            PG8_WAIT_L(8); PG8_BAR; PG8_WAIT_L(0); PG8_MMA(0, 0, At, B0); PG8_BAR; PG8_SCHED;
            PG8_LDB(B1, 1, 1); PG8_STAGE(PG8_SB(1, 0), b3, voffB);
            PG8_BAR; PG8_WAIT_L(0); PG8_MMA(0, 1, At, B1); PG8_BAR;
            PG8_LDA(At, 1, 1); PG8_STAGE(PG8_SA(1, 0), a3, voffA);
            PG8_BAR; PG8_WAIT_L(0); PG8_MMA(1, 0, At, B0); PG8_BAR; PG8_SCHED;
            PG8_STAGE(PG8_SB(1, 1), b3 + hB, voffB);
            PG8_WAIT_V(6); PG8_BAR; PG8_MMA(1, 1, At, B1); PG8_BAR;
            }
        }
        if constexpr (ALIGN_EPI) { if (wr == 0) PG8_BAR; }
        if constexpr (!Epi::AFTER_DRAIN) { E(acc, cur, wr, wc, fr, fq); S.done(cur); }
        if (!has_next) break;
#pragma unroll
        for (int a = 0; a < 2; ++a)
#pragma unroll
            for (int b = 0; b < 2; ++b)
#pragma unroll
                for (int m = 0; m < 4; ++m)
#pragma unroll
                    for (int n = 0; n < 2; ++n) acc[a][b][m][n] = (f32x4){0.f, 0.f, 0.f, 0.f};
        cur = nxt; cA = nA; cB = nB; ++ui;
        if constexpr (ALIGN_EPI) { if (wr == 1) PG8_BAR; }
    }
    PG8_WAIT_V(0);
    if constexpr (!ALIGN_EPI) { if (wr == 0) PG8_BAR; }
    PG8_BAR;
    if constexpr (Epi::AFTER_DRAIN) { E.fused(acc, cur, wr, wc, fr, fq, lds, wid, lane); S.done(cur); }
#undef PG8_SA
#undef PG8_SB
#undef PG8_STAGE
#undef PG8_LDA
#undef PG8_LDB
#undef PG8_MMA
#undef PG8_WAIT_V
#undef PG8_WAIT_L
#undef PG8_BAR
#undef PG8_SCHED
}
}

namespace att {
typedef unsigned short bf16_t;
using bf16x8 = __attribute__((ext_vector_type(8))) short;
using s16x4  = __attribute__((ext_vector_type(4))) short;
using f32x16 = __attribute__((ext_vector_type(16))) float;
using f32x4  = __attribute__((ext_vector_type(4))) float;
using u32x4  = __attribute__((ext_vector_type(4))) unsigned;
#define ADI __device__ __forceinline__
#define SBAR() __builtin_amdgcn_sched_barrier(0)
#define MFMA32(a, b, c) __builtin_amdgcn_mfma_f32_32x32x16_bf16((a), (b), (c), 0, 0, 0)
ADI int crow(int r, int hi) { return (r & 3) + 8 * (r >> 2) + 4 * hi; }
ADI unsigned cvtpk(float lo, float hi) { return pg8::cvt_pk_bf16(lo, hi); }
ADI float bf2f(unsigned short b) { return __uint_as_float((unsigned)b << 16); }
ADI float bflo(unsigned w) { return __uint_as_float(w << 16); }
ADI float bfhi(unsigned w) { return __uint_as_float(w & 0xffff0000u); }
ADI float fexp(float x) { return __builtin_amdgcn_exp2f(x * 1.4426950408889634f); }
template <int RB> ADI int kswz(int row, int colB) { return row * RB + (colB ^ ((RB % 256 == 0 ? (row & 15) : ((row >> 1) & 7)) << 4)); }
ADI int v_st(int k, int c) { const int kk = (k & ~0xC) | ((k & 4) << 1) | ((k & 8) >> 1); return ((kk >> 3) * 4 + (c >> 5)) * 512 + ((kk & 7) * 32 + (c & 31)) * 2; }
ADI int v_rd_base(int lane) { return ((lane & 3) << 3) | (((lane >> 2) & 3) << 6) | (((lane >> 4) & 1) << 5) | (((lane >> 5) & 1) << 8); }
constexpr int v_rd_off(int d0, int ks, int half) { return d0 * 512 + ks * 4096 + half * 2048; }
template <int OFF> ADI s16x4 tr_read(int vb) { s16x4 r; asm volatile("ds_read_b64_tr_b16 %0, %1 offset:%2" : "=&v"(r) : "v"(vb), "i"(OFF) : "memory"); return r; }
#define PKLH(L, H) (bf16x8){L[0], L[1], L[2], L[3], H[0], H[1], H[2], H[3]}
template <int D0> ADI void vfrags(int vb, bf16x8& f0, bf16x8& f1, bf16x8& f2, bf16x8& f3) {
  const s16x4 l0 = tr_read<v_rd_off(D0, 0, 0)>(vb), h0 = tr_read<v_rd_off(D0, 0, 1)>(vb), l1 = tr_read<v_rd_off(D0, 1, 0)>(vb), h1 = tr_read<v_rd_off(D0, 1, 1)>(vb);
  const s16x4 l2 = tr_read<v_rd_off(D0, 2, 0)>(vb), h2 = tr_read<v_rd_off(D0, 2, 1)>(vb), l3 = tr_read<v_rd_off(D0, 3, 0)>(vb), h3 = tr_read<v_rd_off(D0, 3, 1)>(vb);
  asm volatile("s_waitcnt lgkmcnt(0)" ::: "memory"); SBAR();
  f0 = PKLH(l0, h0); f1 = PKLH(l1, h1); f2 = PKLH(l2, h2); f3 = PKLH(l3, h3);
}
template <int D0> ADI void pv_one(f32x16& od, int vb, bf16x8 pa0, bf16x8 pa1, bf16x8 pa2, bf16x8 pa3) {
  bf16x8 f0, f1, f2, f3; vfrags<D0>(vb, f0, f1, f2, f3);
  od = MFMA32(pa0, f0, od); od = MFMA32(pa1, f1, od); od = MFMA32(pa2, f2, od); od = MFMA32(pa3, f3, od);
}
#define PK4(P, BASE, OUT) do { unsigned a0_ = cvtpk(P[BASE + 0], P[BASE + 1]), a1_ = cvtpk(P[BASE + 2], P[BASE + 3]);   \
    unsigned b0_ = cvtpk(P[BASE + 4], P[BASE + 5]), b1_ = cvtpk(P[BASE + 6], P[BASE + 7]);                              \
    auto r0_ = __builtin_amdgcn_permlane32_swap(a0_, b0_, false, false); auto r1_ = __builtin_amdgcn_permlane32_swap(a1_, b1_, false, false); \
    u32x4 w_ = {r0_[0], r1_[0], r0_[1], r1_[1]}; OUT = *reinterpret_cast<bf16x8*>(&w_); } while (0)
ADI float half_swap_max(float v) { auto rr = __builtin_amdgcn_permlane32_swap(__float_as_uint(v), __float_as_uint(v), false, false); return fmaxf(__uint_as_float(rr[0]), __uint_as_float(rr[1])); }
ADI float half_swap_add(float v) { auto rr = __builtin_amdgcn_permlane32_swap(__float_as_uint(v), __float_as_uint(v), false, false); return __uint_as_float(rr[0]) + __uint_as_float(rr[1]); }

constexpr float THR2 = 11.5f;
template <int DQK>
ADI void attn_unit(const bf16_t* __restrict__ Qg, int ldq, const bf16_t* __restrict__ Kg, int ldk, const bf16_t* __restrict__ Vg, int ldv, bf16_t* __restrict__ Og, int ldo, int q0, char* lds) {
  constexpr int RB = DQK * 2, KTB = 64 * RB, ND0 = DQK / 16, NKP = DQK / 64, PPR = DQK / 8;
  int tid_ = threadIdx.x; asm volatile("" : "+v"(tid_));
  const int tid = tid_, wid = __builtin_amdgcn_readfirstlane(tid >> 6), lane = tid & 63, r32 = lane & 31, hi = lane >> 5;
  char* V_lds = lds; char* K_lds = lds + 32768;
  float* ws = (float*)(lds + 32768 + 2 * KTB) + wid * 64; float* li_l = ws; float* al_l = ws + 32;
  const int nt_unit = q0 / 64 + 4, nt_w = q0 / 64 + (wid >> 1) + 1;
  bf16x8 qr[ND0];
  { const bf16_t* Qw = Qg + (size_t)(q0 + wid * 32 + r32) * ldq + hi * 8;
#pragma unroll
    for (int d0 = 0; d0 < ND0; ++d0) qr[d0] = *reinterpret_cast<const bf16x8*>(Qw + d0 * 16); }
  const int sr = tid >> 4, sc = (tid & 15) * 8, vst0 = v_st(sr, sc), vst1 = v_st(32 + sr, sc);
  int krow[NKP], kcb[NKP];
#pragma unroll
  for (int i = 0; i < NKP; ++i) { const int idx = tid + 512 * i; krow[i] = idx / PPR; kcb[i] = (idx % PPR) * 16; }
  const int vb0 = (int)(uintptr_t)V_lds + v_rd_base(lane);
  bf16x8 vs0, vs1, ks[NKP];
#define ALOAD(k0) do { vs0 = *reinterpret_cast<const bf16x8*>(Vg + (size_t)((k0) + sr) * ldv + sc); vs1 = *reinterpret_cast<const bf16x8*>(Vg + (size_t)((k0) + 32 + sr) * ldv + sc); \
    _Pragma("unroll") for (int i_ = 0; i_ < NKP; ++i_) ks[i_] = *reinterpret_cast<const bf16x8*>(Kg + (size_t)((k0) + krow[i_]) * ldk + (kcb[i_] >> 1)); } while (0)
#define AWRITE(b) do { *(bf16x8*)(V_lds + (b) * 16384 + vst0) = vs0; *(bf16x8*)(V_lds + (b) * 16384 + vst1) = vs1; \
    _Pragma("unroll") for (int i_ = 0; i_ < NKP; ++i_) *(bf16x8*)(K_lds + (b) * KTB + kswz<RB>(krow[i_], kcb[i_])) = ks[i_]; } while (0)
  float m_reg = -1e30f, l_reg = 0.f; f32x16 o[4];
#pragma unroll
  for (int d = 0; d < 4; ++d)
#pragma unroll
    for (int r = 0; r < 16; ++r) o[d][r] = 0.f;
  ALOAD(0); AWRITE(0); __syncthreads();
  for (int j = 0; j < nt_unit; ++j) {
    const int buf = j & 1;
    if (j + 1 < nt_unit) ALOAD((j + 1) * 64);
    if (j < nt_w) {
      const char* Ks = K_lds + buf * KTB;
      f32x16 p0, p1;
#pragma unroll
      for (int r = 0; r < 16; ++r) { p0[r] = 0.f; p1[r] = 0.f; }
#pragma unroll
      for (int d0 = 0; d0 < ND0; ++d0) { const int cb = (d0 * 16 + hi * 8) * 2;
        const bf16x8 b0 = *reinterpret_cast<const bf16x8*>(Ks + kswz<RB>(r32, cb));
        const bf16x8 b1 = *reinterpret_cast<const bf16x8*>(Ks + kswz<RB>(32 + r32, cb));
        p0 = MFMA32(b0, qr[d0], p0); p1 = MFMA32(b1, qr[d0], p1);
        if ((d0 & 3) == 3) SBAR(); }
      float pmax = p0[0];
#pragma unroll
      for (int r = 1; r < 16; ++r) pmax = fmaxf(pmax, p0[r]);
#pragma unroll
      for (int r = 0; r < 16; ++r) pmax = fmaxf(pmax, p1[r]);
      pmax = half_swap_max(pmax);
      float mn, alpha;
      if (__all(pmax - m_reg <= THR2)) { mn = m_reg; alpha = 1.f; }
      else { mn = fmaxf(m_reg, pmax); alpha = __builtin_amdgcn_exp2f(m_reg - mn); m_reg = mn; }
      float ps = 0.f;
#pragma unroll
      for (int r = 0; r < 16; ++r) { p0[r] = __builtin_amdgcn_exp2f(p0[r] - mn); p1[r] = __builtin_amdgcn_exp2f(p1[r] - mn); ps += p0[r] + p1[r]; }
      ps = half_swap_add(ps);
      l_reg = l_reg * alpha + ps;
      bf16x8 pa0, pa1, pa2, pa3;
      PK4(p0, 0, pa0); PK4(p0, 8, pa1); PK4(p1, 0, pa2); PK4(p1, 8, pa3);
      if (__any(alpha < 1.f)) { if (hi == 0) al_l[r32] = alpha; asm volatile("s_waitcnt lgkmcnt(0)" ::: "memory");
#pragma unroll
        for (int r = 0; r < 16; ++r) { const float a = al_l[crow(r, hi)];
#pragma unroll
          for (int d = 0; d < 4; ++d) o[d][r] *= a; }
        asm volatile("s_waitcnt lgkmcnt(0)" ::: "memory"); }
      const int vb = vb0 + buf * 16384;
      pv_one<0>(o[0], vb, pa0, pa1, pa2, pa3); pv_one<1>(o[1], vb, pa0, pa1, pa2, pa3); pv_one<2>(o[2], vb, pa0, pa1, pa2, pa3); pv_one<3>(o[3], vb, pa0, pa1, pa2, pa3);
    }
    if (j + 1 < nt_unit) AWRITE(buf ^ 1);
    __syncthreads();
  }
  if (hi == 0) li_l[r32] = l_reg; asm volatile("s_waitcnt lgkmcnt(0)" ::: "memory");
  bf16_t* Ow = Og + (size_t)(q0 + wid * 32) * ldo;
#pragma unroll
  for (int r = 0; r < 16; ++r) { const int orow = crow(r, hi); const float rl = __builtin_amdgcn_rcpf(li_l[orow]);
#pragma unroll
    for (int d0 = 0; d0 < 4; ++d0) Ow[(size_t)orow * ldo + d0 * 32 + r32] = (bf16_t)(cvtpk(o[d0][r] * rl, 0.f) & 0xffffu); }
  asm volatile("s_waitcnt lgkmcnt(0)" ::: "memory");
#undef ALOAD
#undef AWRITE
}

ADI void softmax_tile(f32x16& p0, f32x16& p1, float& m_reg, float& l_reg, float& alpha, bf16x8& pa0, bf16x8& pa1, bf16x8& pa2, bf16x8& pa3) {
  float pmax = p0[0];
#pragma unroll
  for (int r = 1; r < 16; ++r) pmax = fmaxf(pmax, p0[r]);
#pragma unroll
  for (int r = 0; r < 16; ++r) pmax = fmaxf(pmax, p1[r]);
  pmax = half_swap_max(pmax);
  float mn;
  if (__all(pmax - m_reg <= THR2)) { mn = m_reg; alpha = 1.f; }
  else { mn = fmaxf(m_reg, pmax); alpha = __builtin_amdgcn_exp2f(m_reg - mn); m_reg = mn; }
  float ps = 0.f;
#pragma unroll
  for (int r = 0; r < 16; ++r) { p0[r] = __builtin_amdgcn_exp2f(p0[r] - mn); p1[r] = __builtin_amdgcn_exp2f(p1[r] - mn); ps += p0[r] + p1[r]; }
  ps = half_swap_add(ps);
  l_reg = l_reg * alpha + ps;
  PK4(p0, 0, pa0); PK4(p0, 8, pa1); PK4(p1, 0, pa2); PK4(p1, 8, pa3);
}
ADI void attn_diff_unit(const bf16_t* __restrict__ Zg, int ldz, int h, bf16_t* __restrict__ Og, int ldo, int q0, float lam, float post, const float* __restrict__ gh, char* lds, char* wsl) {
  int tid_ = threadIdx.x; asm volatile("" : "+v"(tid_));
  const int tid = tid_, wid = __builtin_amdgcn_readfirstlane(tid >> 6), lane = tid & 63, r32 = lane & 31, hi = lane >> 5;
  char* V_lds = lds; char* K_lds = lds + 32768; char* Q_lds = lds + 65536;
  float* ws = (float*)wsl + wid * 128; float* al0 = ws; float* al1 = ws + 32; float* li0 = ws + 64; float* li1 = ws + 96;
  const int nt_unit = q0 / 64 + 4, nt_w = q0 / 64 + (wid >> 1) + 1;
  const bf16_t* Qg = Zg + h * 128; const bf16_t* Kg = Zg + 1024 + h * 128; const bf16_t* Vg = Zg + 2048 + h * 128;
  const int sr = tid >> 4, sc = (tid & 15) * 8, vst0 = v_st(sr, sc), vst1 = v_st(32 + sr, sc), kst0 = kswz<256>(sr, sc * 2), kst1 = kswz<256>(32 + sr, sc * 2);
#pragma unroll
  for (int i = 0; i < 8; ++i) { const int row = sr + 32 * i;
    *(bf16x8*)(Q_lds + kswz<256>(row, sc * 2)) = *reinterpret_cast<const bf16x8*>(Qg + (size_t)(q0 + row) * ldz + sc); }
  const int vb0 = (int)(uintptr_t)V_lds + v_rd_base(lane);
  const char* Qw = Q_lds + (wid * 32 + r32) * 256; const int qsw = ((wid * 32 + r32) & 15) << 4;
  bf16x8 vs0, vs1, ks0, ks1;
#define DLOAD(k0) do { vs0 = *reinterpret_cast<const bf16x8*>(Vg + (size_t)((k0) + sr) * ldz + sc); vs1 = *reinterpret_cast<const bf16x8*>(Vg + (size_t)((k0) + 32 + sr) * ldz + sc); \
    ks0 = *reinterpret_cast<const bf16x8*>(Kg + (size_t)((k0) + sr) * ldz + sc); ks1 = *reinterpret_cast<const bf16x8*>(Kg + (size_t)((k0) + 32 + sr) * ldz + sc); } while (0)
#define DWRITE(b) do { *(bf16x8*)(V_lds + (b) * 16384 + vst0) = vs0; *(bf16x8*)(V_lds + (b) * 16384 + vst1) = vs1; \
    *(bf16x8*)(K_lds + (b) * 16384 + kst0) = ks0; *(bf16x8*)(K_lds + (b) * 16384 + kst1) = ks1; } while (0)
  float m0 = -1e30f, l0 = 0.f, m1 = -1e30f, l1 = 0.f; f32x16 o0[4], o1[4];
#pragma unroll
  for (int d = 0; d < 4; ++d)
#pragma unroll
    for (int r = 0; r < 16; ++r) { o0[d][r] = 0.f; o1[d][r] = 0.f; }
  DLOAD(0); DWRITE(0); __syncthreads();
  for (int j = 0; j < nt_unit; ++j) {
    const int buf = j & 1;
    if (j + 1 < nt_unit) DLOAD((j + 1) * 64);
    if (j < nt_w) {
      const char* Ks = K_lds + buf * 16384;
      const int vb = vb0 + buf * 16384;
#define DSTREAM(COFF, MREG, LREG, ALV, OACC) do { bf16x8 pa0, pa1, pa2, pa3; float alpha; \
        { f32x16 p0, p1; \
          _Pragma("unroll") for (int r = 0; r < 16; ++r) { p0[r] = 0.f; p1[r] = 0.f; } \
          _Pragma("unroll") for (int d0 = 0; d0 < 4; ++d0) { const int cb = ((COFF) + d0 * 16 + hi * 8) * 2; \
            const bf16x8 qf = *reinterpret_cast<const bf16x8*>(Qw + (cb ^ qsw)); \
            const bf16x8 b0 = *reinterpret_cast<const bf16x8*>(Ks + kswz<256>(r32, cb)); \
            const bf16x8 b1 = *reinterpret_cast<const bf16x8*>(Ks + kswz<256>(32 + r32, cb)); \
            p0 = MFMA32(b0, qf, p0); p1 = MFMA32(b1, qf, p1); } \
          softmax_tile(p0, p1, MREG, LREG, alpha, pa0, pa1, pa2, pa3); } \
        if (__any(alpha < 1.f)) { if (hi == 0) ALV[r32] = alpha; asm volatile("s_waitcnt lgkmcnt(0)" ::: "memory"); \
          _Pragma("unroll") for (int r = 0; r < 16; ++r) { const float a = ALV[crow(r, hi)]; \
            _Pragma("unroll") for (int d = 0; d < 4; ++d) OACC[d][r] *= a; } \
          asm volatile("s_waitcnt lgkmcnt(0)" ::: "memory"); } \
        pv_one<0>(OACC[0], vb, pa0, pa1, pa2, pa3); pv_one<1>(OACC[1], vb, pa0, pa1, pa2, pa3); pv_one<2>(OACC[2], vb, pa0, pa1, pa2, pa3); pv_one<3>(OACC[3], vb, pa0, pa1, pa2, pa3); } while (0)
      DSTREAM(0, m0, l0, al0, o0);
      SBAR();
      DSTREAM(64, m1, l1, al1, o1);
#undef DSTREAM
    }
    if (j + 1 < nt_unit) DWRITE(buf ^ 1);
    __syncthreads();
  }
  if (hi == 0) { li0[r32] = l0; li1[r32] = l1; } asm volatile("s_waitcnt lgkmcnt(0)" ::: "memory");
  float gv[4];
#pragma unroll
  for (int d = 0; d < 4; ++d) gv[d] = gh[d * 32 + r32];
  bf16_t* Ow = Og + (size_t)(q0 + wid * 32) * ldo;
#pragma unroll
  for (int r = 0; r < 16; ++r) { const int orow = crow(r, hi); const float ra = __builtin_amdgcn_rcpf(li0[orow]), rb = lam * __builtin_amdgcn_rcpf(li1[orow]);
    float ss = 0.f;
#pragma unroll
    for (int d = 0; d < 4; ++d) { const float v = o0[d][r] * ra - o1[d][r] * rb; o0[d][r] = v; ss += v * v; }
    ss += __shfl_xor(ss, 1); ss += __shfl_xor(ss, 2); ss += __shfl_xor(ss, 4); ss += __shfl_xor(ss, 8); ss += __shfl_xor(ss, 16);
    const float rs = post / sqrtf(ss * (1.f / 128.f) + 1e-6f);
#pragma unroll
    for (int d = 0; d < 4; ++d) Ow[(size_t)orow * ldo + d * 32 + r32] = (bf16_t)(cvtpk(o0[d][r] * rs * gv[d], 0.f) & 0xffffu); }
  asm volatile("s_waitcnt lgkmcnt(0)" ::: "memory");
#undef DLOAD
#undef DWRITE
}
}

#define GAS __attribute__((address_space(1)))
#define LAS __attribute__((address_space(3)))
typedef unsigned short bf16;
typedef unsigned v4u __attribute__((ext_vector_type(4)));
typedef float f32x4 __attribute__((ext_vector_type(4)));
typedef short bf16x8 __attribute__((ext_vector_type(8)));
typedef GAS unsigned gu32;
typedef GAS unsigned long long gu64;
#define RLX_AGENT __ATOMIC_RELAXED, __HIP_MEMORY_SCOPE_AGENT
#define LDS_WAIT() asm volatile("s_waitcnt lgkmcnt(0)" ::: "memory")
#define VM_WAIT() asm volatile("s_waitcnt vmcnt(0)" ::: "memory")
#define DI __device__ __forceinline__
DI unsigned f2bf(float f) { unsigned u = __builtin_bit_cast(unsigned, f); return (u + 0x7fffu + ((u >> 16) & 1u)) >> 16; }
DI unsigned pk2(float lo, float hi) { return f2bf(lo) | (f2bf(hi) << 16); }

constexpr int NWAVES = 8;
constexpr int M = 16384, D = 1024, FF = 2816, SEQ = 4096, NB = 4, DEPTH = 4;
constexpr int ZE = 2816, ZO = 3072;
constexpr float EPS = 1e-6f;
constexpr size_t MiB = 1u << 20;
constexpr size_t WS_CTL = 0, CTL_ZERO_BYTES = 1 * MiB;
constexpr size_t WS_LB = 1 * MiB;
constexpr size_t WS_TM = 2 * MiB;
constexpr size_t WS_TD = 6 * MiB;
constexpr size_t WS_W = 8 * MiB;
constexpr size_t W_GU0 = 0, W_D0 = 11534336, W_GU1 = 17301504, W_D1 = 28835840, W_MIX = 34603008;
constexpr size_t W_EIN = W_MIX, W_EUQ = W_MIX + 5767168, W_EUKV = W_EUQ + 589824, W_EOUT = W_EUKV + 524288;
constexpr size_t W_OIN = W_MIX, W_OOUT = W_MIX + 6291456;
constexpr size_t WS_XN = 50 * MiB;
constexpr size_t WS_Y = 82 * MiB;
constexpr size_t WS_Z = 114 * MiB;
constexpr size_t WS_Q = 210 * MiB, WS_K = 234 * MiB, WS_V = 258 * MiB;
constexpr size_t WS_UT = 274 * MiB;
constexpr size_t WS_OI = 306 * MiB;
constexpr size_t WS_QD = 338 * MiB;
constexpr size_t WS_DC = 354 * MiB;
constexpr size_t WS_SP = 355 * MiB;
constexpr size_t WS_END = 357 * MiB;
constexpr int CW_BAR = 4096;
constexpr int RING_OFF = 0, RING_BYTES = 131072;
constexpr int LDSCTL_OFF = RING_BYTES, MISC_OFF = LDSCTL_OFF + 320;
constexpr int LDS_BYTES = 147456;
constexpr int RS_OFF = 132096;

#define XB_TMO      128
#define XB_XCNT(j)  (256  + 64 * (j))
#define XB_XSUB(j)  (1280 + 64 * (j))
#define XB_XGEN(j)  (2304 + 64 * (j))
#define XB_TOP      3328
#define XB_TOPGEN   3392
#define XCD_BAR_WORDS 3456
#define XB_SPIN_CAP (1u << 21)

__device__ __forceinline__ unsigned xb_ld(unsigned* p)              { return __hip_atomic_load(p, __ATOMIC_RELAXED, __HIP_MEMORY_SCOPE_AGENT); }
__device__ __forceinline__ unsigned xb_add(unsigned* p, unsigned v) { return __hip_atomic_fetch_add(p, v, __ATOMIC_RELAXED, __HIP_MEMORY_SCOPE_AGENT); }
__device__ __forceinline__ unsigned xb_xcc_id() { return (unsigned)__builtin_amdgcn_s_getreg((3 << 11) | 20) & 0xFu; }
#define XB_SPIN(cond, bar) do { unsigned _sp = 0; while (cond) { __builtin_amdgcn_s_sleep(1); \
    if ((++_sp & 255u) == 0u) { if (xb_ld(&(bar)[XB_TMO])) break; if (_sp > XB_SPIN_CAP) { atomicAdd(&(bar)[XB_TMO], 1u); break; } } } } while (0)

struct XcdBarrier {
    unsigned* bar; unsigned x;
    volatile LAS unsigned* st;
};

__device__ __forceinline__ XcdBarrier xcd_barrier_post(unsigned* bar, volatile LAS unsigned* st) {
    XcdBarrier b; b.bar = bar; b.x = xb_xcc_id(); b.st = st;
    if (threadIdx.x == 0) (void)xb_add(&bar[XB_XCNT(b.x)], 1u);
    return b;
}
__device__ __forceinline__ void xcd_barrier_complete(unsigned* bar, unsigned x, unsigned& nloc, unsigned& nx) {
    const unsigned G = gridDim.x * gridDim.y * gridDim.z;
    unsigned sum, cnt, mine, sp = 0u;
    for (;;) {
        sum = 0u; cnt = 0u; mine = 0u;
#pragma unroll
        for (unsigned j = 0; j < 16; ++j) { const unsigned c = xb_ld(&bar[XB_XCNT(j)]); sum += c; cnt += (c > 0u) ? 1u : 0u; mine = (j == x) ? c : mine; }
        if (sum == G) break;
        __builtin_amdgcn_s_sleep(1);
        if ((++sp & 255u) == 0u) { if (xb_ld(&bar[XB_TMO])) break; if (sp > XB_SPIN_CAP) { atomicAdd(&bar[XB_TMO], 1u); break; } }
    }
    nloc = mine > 0u ? mine : 1u; nx = cnt > 0u ? cnt : 1u;
}

__device__ __forceinline__ void xcd_barrier(const XcdBarrier& b) {
    asm volatile("s_waitcnt vmcnt(0)" ::: "memory");
    __syncthreads();
    if (threadIdx.x == 0) {
        unsigned* bar = b.bar;
        __builtin_amdgcn_s_waitcnt(0);
        unsigned nloc = b.st[0], nx = b.st[1];
        if (nloc == 0u) { xcd_barrier_complete(bar, b.x, nloc, nx); b.st[0] = nloc; b.st[1] = nx; }
        const unsigned old = xb_add(&bar[XB_XSUB(b.x)], 1u);
        const unsigned gen = old / nloc;
        if (old + 1u == (gen + 1u) * nloc) {
            __builtin_amdgcn_fence(__ATOMIC_RELEASE, "agent");
            asm volatile("s_waitcnt vmcnt(0)" ::: "memory");
            const unsigned og = xb_add(&bar[XB_TOP], 1u);
            const unsigned tg = og / nx;
            if (og + 1u == (tg + 1u) * nx) xb_add(&bar[XB_TOPGEN], 1u);
            else XB_SPIN(xb_ld(&bar[XB_TOPGEN]) == tg, bar);
            __builtin_amdgcn_fence(__ATOMIC_ACQUIRE, "agent");
            xb_add(&bar[XB_XGEN(b.x)], 1u);
            asm volatile("s_waitcnt vmcnt(0)" ::: "memory");
        } else {
            XB_SPIN(xb_ld(&bar[XB_XGEN(b.x)]) == gen, bar);
            __builtin_amdgcn_fence(__ATOMIC_ACQUIRE, "agent");
            asm volatile("s_waitcnt vmcnt(0)" ::: "memory");
        }
    }
    __syncthreads();
}


struct Args { const void* in[18]; float* out; unsigned char* ws; float invf_m[32]; float invf_d[8]; float linit[2]; int ph_lo, ph_hi, li, pad; };
#define KA __attribute__((address_space(4)))
struct Frame {
    LAS unsigned char* lds; unsigned char* ldsg;
    volatile LAS unsigned* MISC;
    gu32* ctl;
    int tid, lane, wave, vcu, G, bx;
    unsigned char* ws;
};
DI float wave_sum(float v) {
#pragma unroll
    for (int o = 1; o < 64; o <<= 1) v += __shfl_xor(v, o);
    return v;
}
using att::bflo; using att::bfhi; using att::fexp; using att::bf2f;

enum { CV_GU = 0, CV_ID = 1, CV_EIN = 2, CV_EUQ = 3, CV_OIN = 4 };
DI void map_col(int kind, int n, int& col, int& which) {
    which = 0; col = n;
    if (kind == CV_GU) { const int pn = n >> 8, r = n & 255; which = (r < 128) ? 0 : 1; col = pn * 128 + (r & 127); }
    else if (kind == CV_EIN) {
        if (n < 640) col = n;
        else if (n < 704) { const int p = n - 640, j = p >> 3, nn = (p >> 2) & 1, i = p & 3; col = 640 + 32 * nn + 4 * j + i; }
        else if (n < 768) { which = -1; col = 0; }
        else col = n - 64;
    } else if (kind == CV_EUQ) {
        if (n < 512) { col = (n >> 7) * 192 + (n & 127); }
        else { const int r = n - 512, head = r >> 6, p = r & 63, j = p >> 3, nn = (p >> 2) & 1, i = p & 3; col = head * 192 + 128 + 32 * nn + 4 * j + i; }
    } else if (kind == CV_OIN) {
        if (n < 2048) { const int p = n & 63; if (p < 16) { const int j = p >> 3, nn = (p >> 2) & 1, i = p & 3; col = (n & ~63) + 8 * nn + 4 * j + i; } }
    }
}
DI void cvt_item(int kind, const float* a, const float* b, const float* scale, int ld, int K, int Ndst, bf16* WT, LAS float* scr, int item, int lane) {
    const int nblk = Ndst / 32, kb = item / nblk, nb = item % nblk, k0 = 64 * kb, n0 = 32 * nb;
    int col, which; map_col(kind, n0 + (lane & 31), col, which);
    const float* src = (which == 1) ? b : a;
#pragma unroll 8
    for (int i = 0; i < 32; ++i) { const int kk = 2 * i + (lane >> 5); float v = 0.f;
        if (which >= 0) { v = src[(size_t)(k0 + kk) * ld + col]; if (scale) v *= scale[k0 + kk]; }
        scr[kk * 33 + (lane & 31)] = v; }
    LDS_WAIT(); asm volatile("" ::: "memory");
    const int c = lane & 7;
#pragma unroll
    for (int j = 0; j < 4; ++j) { const int n = (lane >> 3) + 8 * j; const LAS float* s = scr + (8 * c) * 33 + n;
        v4u o; o.x = pk2(s[0 * 33], s[1 * 33]); o.y = pk2(s[2 * 33], s[3 * 33]); o.z = pk2(s[4 * 33], s[5 * 33]); o.w = pk2(s[6 * 33], s[7 * 33]);
        *(GAS v4u*)(WT + (size_t)(n0 + n) * K + k0 + 8 * c) = o; }
    LDS_WAIT(); asm volatile("" ::: "memory");
}
DI void convert_layer(Frame& F, KA const Args* A, int l) {
    LAS float* scr = (LAS float*)(F.lds + RING_OFF + F.wave * 16384);
    const int gw = F.vcu * NWAVES + F.wave, NGW = F.G * NWAVES;
    unsigned char* W = F.ws + WS_W;
    const float* wg = (const float*)A->in[3]; const float* wu = (const float*)A->in[4]; const float* wd = (const float*)A->in[5];
    constexpr int I_GU = 16 * 176, I_D = 44 * 32, I_EIN = 16 * 88, I_EUQ = 6 * 24, I_EUKV = 4 * 32, I_OUT = 16 * 32, I_OIN = 16 * 96;
    const bool even = (l & 1) == 0; const int j = l >> 1;
    const int nmix = even ? (I_EIN + I_EUQ + I_EUKV + I_OUT) : (I_OIN + I_OUT);
    const int total = 2 * (I_GU + I_D) + nmix;
    for (int it = gw; it < total; it += NGW) {
        int r = it;
        if (r < 2 * (I_GU + I_D)) {
            const int s = r / (I_GU + I_D); r -= s * (I_GU + I_D);
            const size_t wo = (size_t)(l * 2 + s) * 1024 * 2816;
            if (r < I_GU) cvt_item(CV_GU, wg + wo, wu + wo, nullptr, 2816, 1024, 5632, (bf16*)(W + (s ? W_GU1 : W_GU0)), scr, r, F.lane);
            else cvt_item(CV_ID, wd + wo, nullptr, nullptr, 1024, 2816, 1024, (bf16*)(W + (s ? W_D1 : W_D0)), scr, r - I_GU, F.lane);
            continue;
        }
        r -= 2 * (I_GU + I_D);
        if (even) {
            if (r < I_EIN) { cvt_item(CV_EIN, (const float*)A->in[6] + (size_t)j * 1024 * 2752, nullptr, nullptr, 2752, 1024, 2816, (bf16*)(W + W_EIN), scr, r, F.lane); continue; } r -= I_EIN;
            if (r < I_EUQ) { cvt_item(CV_EUQ, (const float*)A->in[8] + (size_t)j * 384 * 768, nullptr, (const float*)A->in[7] + j * 384, 768, 384, 768, (bf16*)(W + W_EUQ), scr, r, F.lane); continue; } r -= I_EUQ;
            if (r < I_EUKV) { cvt_item(CV_ID, (const float*)A->in[10] + (size_t)j * 256 * 1024, nullptr, (const float*)A->in[9] + j * 256, 1024, 256, 1024, (bf16*)(W + W_EUKV), scr, r, F.lane); continue; } r -= I_EUKV;
            cvt_item(CV_ID, (const float*)A->in[13] + (size_t)j * 1024 * 1024, nullptr, nullptr, 1024, 1024, 1024, (bf16*)(W + W_EOUT), scr, r, F.lane);
        } else {
            if (r < I_OIN) { cvt_item(CV_OIN, (const float*)A->in[14] + (size_t)j * 1024 * 3072, nullptr, nullptr, 3072, 1024, 3072, (bf16*)(W + W_OIN), scr, r, F.lane); continue; } r -= I_OIN;
            cvt_item(CV_ID, (const float*)A->in[17] + (size_t)j * 1024 * 1024, nullptr, nullptr, 1024, 1024, 1024, (bf16*)(W + W_OOUT), scr, r, F.lane);
        }
    }
}
constexpr int TR = 4;
DI void thin_rows(Frame& F, const float* xin, float* xout, const bf16* Y, const float* gpost, float c, const float* gpre, bf16* XN) {
    const int gw = F.vcu * NWAVES + F.wave, NGW = F.G * NWAVES;
    f32x4 gp[4], gq[4];
#pragma unroll
    for (int j = 0; j < 4; ++j) { gp[j] = Y ? *((const GAS f32x4*)gpost + F.lane + 64 * j) : (f32x4){0.f, 0.f, 0.f, 0.f}; gq[j] = gpre ? *((const GAS f32x4*)gpre + F.lane + 64 * j) : (f32x4){0.f, 0.f, 0.f, 0.f}; }
    for (int m0 = gw; m0 < M; m0 += TR * NGW) {
        f32x4 x[TR][4]; unsigned long long yw[TR][4];
#pragma unroll
        for (int r = 0; r < TR; ++r) { const int m = m0 + r * NGW; if (m < M) {
            const GAS f32x4* xr = (const GAS f32x4*)(xin + (size_t)m * D) + F.lane;
#pragma unroll
            for (int j = 0; j < 4; ++j) x[r][j] = __builtin_nontemporal_load(xr + 64 * j);
            if (Y) { const GAS unsigned long long* yr = (const GAS unsigned long long*)(Y + (size_t)m * D) + F.lane;
#pragma unroll
                for (int j = 0; j < 4; ++j) yw[r][j] = __builtin_nontemporal_load(yr + 64 * j); } } }
#pragma unroll
        for (int r = 0; r < TR; ++r) { const int m = m0 + r * NGW; if (m < M) {
            if (Y) {
                f32x4 y[4]; float ss = 0.f;
#pragma unroll
                for (int j = 0; j < 4; ++j) { const unsigned lo = (unsigned)yw[r][j], hi = (unsigned)(yw[r][j] >> 32);
                    y[j] = (f32x4){bflo(lo), bfhi(lo), bflo(hi), bfhi(hi)}; ss += (y[j].x * y[j].x + y[j].y * y[j].y) + (y[j].z * y[j].z + y[j].w * y[j].w); }
                const float rs = c / sqrtf(wave_sum(ss) * (1.f / D) + EPS);
                GAS f32x4* xo = (GAS f32x4*)(xout + (size_t)m * D) + F.lane;
#pragma unroll
                for (int j = 0; j < 4; ++j) { x[r][j] = x[r][j] + y[j] * gp[j] * rs; __builtin_nontemporal_store(x[r][j], xo + 64 * j); }
            }
            if (gpre) {
                float ss2 = 0.f;
#pragma unroll
                for (int j = 0; j < 4; ++j) ss2 += (x[r][j].x * x[r][j].x + x[r][j].y * x[r][j].y) + (x[r][j].z * x[r][j].z + x[r][j].w * x[r][j].w);
                const float rs2 = 1.f / sqrtf(wave_sum(ss2) * (1.f / D) + EPS);
                GAS unsigned long long* o8 = (GAS unsigned long long*)(XN + (size_t)m * D) + F.lane;
#pragma unroll
                for (int j = 0; j < 4; ++j) { const f32x4 v = x[r][j] * gq[j] * rs2;
                    __builtin_nontemporal_store((unsigned long long)pk2(v.x, v.y) | ((unsigned long long)pk2(v.z, v.w) << 32), o8 + 64 * j); }
            } } }
    }
}
DI void build_tables(Frame& F, KA const Args* A) {
    const int* pos = (const int*)A->in[1];
    float* TM = (float*)(F.ws + WS_TM); float* TD = (float*)(F.ws + WS_TD); float* LB = (float*)(F.ws + WS_LB);
    const int gt = F.vcu * 512 + F.tid, NT = F.G * 512;
    for (int idx = gt; idx < M * 40; idx += NT) {
        const int row = idx / 40, i = idx % 40;
        const float p = (float)pos[row];
        const float invf = (i < 32) ? A->invf_m[i] : A->invf_d[i - 32];
        const float ang = p * invf;
        const double rev = (double)ang * 0.15915494309189533577;
        const float fr = (float)(rev - __builtin_rint(rev));
        const float cs = __builtin_amdgcn_cosf(fr), sn = __builtin_amdgcn_sinf(fr);
        if (i < 32) { TM[(size_t)row * 64 + i] = cs; TM[(size_t)row * 64 + 32 + i] = sn; }
        else { TD[(size_t)row * 16 + (i - 32)] = cs; TD[(size_t)row * 16 + 8 + (i - 32)] = sn; }
    }
    const float* lg = (const float*)A->in[11];
    for (int i = gt; i < 512; i += NT) {
        const float l0 = lg[i], l1 = lg[512 + i], mx = fmaxf(l0, l1), e0 = fexp(l0 - mx), e1 = fexp(l1 - mx), w0 = e0 / (e0 + e1), w1 = e1 / (e0 + e1);
        LB[i] = w0 - w0; LB[512 + i] = (w0 + w1) - w0;
    }
}

DI void fill_rs(Frame& F, const pg8::StaticOrder& S, const float* SP, int off, int cnt4, float inv_n, float scale, LAS float* RS, LAS int* RSPM) {
    pg8::Unit u;
    if (F.tid < 4) RSPM[F.tid] = -1;
    __syncthreads();
    for (int i = 0; i < 4; ++i) { if (!S.next(i, u)) break;
        if (F.tid == 0) RSPM[i] = u.pm;
        if (F.tid < 256) { const float* p = SP + (size_t)(u.pm * 256 + F.tid) * 20 + off; float ss = 0.f;
            for (int c = 0; c < cnt4; ++c) { const f32x4 a = *(const f32x4*)(p + 4 * c); ss += (a[0] + a[1]) + (a[2] + a[3]); }
            RS[i * 256 + F.tid] = scale / sqrtf(ss * inv_n + EPS); } }
    __syncthreads();
}
DI void hgrn_h1_unit(Frame& F, int unit, int j) {
    using namespace att;
    const bf16* Z = (const bf16*)(F.ws + WS_Z); const float* LBt = (const float*)(F.ws + WS_LB) + j * 512;
    bf16* QD = (bf16*)(F.ws + WS_QD); float* OI = (float*)(F.ws + WS_OI); bf16* UT = (bf16*)(F.ws + WS_UT); float* DC = (float*)(F.ws + WS_DC);
    const int bh = unit >> 6, c = unit & 63, b = bh >> 2, h = bh & 3, row0 = b * SEQ + c * 64;
    unsigned char* lds = F.ldsg;
    constexpr int LP = 132;
    float* L = (float*)lds; float* SEG = (float*)(lds + 33792);
    char* QM = (char*)lds + 36864; char* KM = (char*)lds + 53248; char* KT = (char*)lds + 69632; char* VI = (char*)lds + 86016;
    const int tid = F.tid, wid = F.wave, lane = F.lane, r32 = lane & 31, hi = lane >> 5;
    const int sr = tid >> 4, sc = (tid & 15) * 8;
    float kk[2][8];
#pragma unroll
    for (int e = 0; e < 2; ++e) { const int rr = sr + 32 * e;
        const v4u zf = *(const v4u*)(Z + (size_t)(row0 + rr) * ZE + 1280 + h * 128 + sc);
        const f32x4 lb0 = *(const f32x4*)(LBt + h * 128 + sc), lb1 = *(const f32x4*)(LBt + h * 128 + sc + 4);
        float zv[8] = {bflo(zf.x), bfhi(zf.x), bflo(zf.y), bfhi(zf.y), bflo(zf.z), bfhi(zf.z), bflo(zf.w), bfhi(zf.w)};
        float lf[8];
#pragma unroll
        for (int i = 0; i < 8; ++i) { const float lb = (i < 4) ? lb0[i & 3] : lb1[i & 3];
            const float sig = __builtin_amdgcn_rcpf(1.f + fexp(-zv[i]));
            const float f = lb + (1.f - lb) * sig;
            lf[i] = __builtin_amdgcn_logf(fmaxf(f, 1e-30f)) * 0.69314718055994531f;
            kk[e][i] = (1.f - lb) * (1.f - sig); }
        *(f32x4*)(L + rr * LP + sc) = (f32x4){lf[0], lf[1], lf[2], lf[3]}; *(f32x4*)(L + rr * LP + sc + 4) = (f32x4){lf[4], lf[5], lf[6], lf[7]};
    }
    __syncthreads();
    { const int col = tid & 127, seg = tid >> 7; float run = 0.f;
#pragma unroll
      for (int i = 0; i < 16; ++i) { run += L[(16 * seg + i) * LP + col]; L[(16 * seg + i) * LP + col] = run; }
      SEG[seg * 128 + col] = run;
      __syncthreads();
      float off = 0.f;
#pragma unroll
      for (int s = 0; s < 3; ++s) off += (s < seg) ? SEG[s * 128 + col] : 0.f;
#pragma unroll
      for (int i = 0; i < 16; ++i) L[(16 * seg + i) * LP + col] += off;
    }
    __syncthreads();
#pragma unroll
    for (int e = 0; e < 2; ++e) { const int rr = sr + 32 * e;
        const v4u zq = *(const v4u*)(Z + (size_t)(row0 + rr) * ZE + 768 + h * 128 + sc);
        const v4u zi = *(const v4u*)(Z + (size_t)(row0 + rr) * ZE + 1792 + h * 128 + sc);
        float q[8] = {bflo(zq.x), bfhi(zq.x), bflo(zq.y), bfhi(zq.y), bflo(zq.z), bfhi(zq.z), bflo(zq.w), bfhi(zq.w)};
        float qm[8], km[8], kt[8], qd[8];
#pragma unroll
        for (int i = 0; i < 8; ++i) { const float bc = L[rr * LP + sc + i], bl = L[63 * LP + sc + i], rf = L[31 * LP + sc + i];
            qm[i] = q[i] * fexp(bc - rf); km[i] = kk[e][i] * fexp(rf - bc); kt[i] = kk[e][i] * fexp(bl - bc); qd[i] = q[i] * fexp(bc); }
        *(v4u*)(QM + kswz<256>(rr, sc * 2)) = (v4u){cvtpk(qm[0], qm[1]), cvtpk(qm[2], qm[3]), cvtpk(qm[4], qm[5]), cvtpk(qm[6], qm[7])};
        *(v4u*)(KM + kswz<256>(rr, sc * 2)) = (v4u){cvtpk(km[0], km[1]), cvtpk(km[2], km[3]), cvtpk(km[4], km[5]), cvtpk(km[6], km[7])};
        *(v4u*)(KT + v_st(rr, sc)) = (v4u){cvtpk(kt[0], kt[1]), cvtpk(kt[2], kt[3]), cvtpk(kt[4], kt[5]), cvtpk(kt[6], kt[7])};
        *(v4u*)(VI + v_st(rr, sc)) = zi;
        *(v4u*)(QD + (size_t)(row0 + rr) * 512 + h * 128 + sc) = (v4u){cvtpk(qd[0], qd[1]), cvtpk(qd[2], qd[3]), cvtpk(qd[4], qd[5]), cvtpk(qd[6], qd[7])};
    }
    if (tid < 128) DC[(size_t)unit * 128 + tid] = fexp(L[63 * LP + tid]);
    __syncthreads();
    const int tb = wid & 1, vb = wid >> 1;
    f32x16 p0, p1;
#pragma unroll
    for (int r = 0; r < 16; ++r) { p0[r] = 0.f; p1[r] = 0.f; }
#pragma unroll
    for (int d0 = 0; d0 < 8; ++d0) { const int cb = (d0 * 16 + hi * 8) * 2;
        const bf16x8 bq = *reinterpret_cast<const bf16x8*>(QM + kswz<256>(32 * tb + r32, cb));
        const bf16x8 a0 = *reinterpret_cast<const bf16x8*>(KM + kswz<256>(r32, cb));
        const bf16x8 a1 = *reinterpret_cast<const bf16x8*>(KM + kswz<256>(32 + r32, cb));
        p0 = MFMA32(a0, bq, p0); p1 = MFMA32(a1, bq, p1); }
    { const int t = 32 * tb + r32;
#pragma unroll
      for (int r = 0; r < 16; ++r) { const int s0 = crow(r, hi); if (s0 > t) p0[r] = 0.f; if (s0 + 32 > t) p1[r] = 0.f; } }
    bf16x8 pa0, pa1, pa2, pa3;
    PK4(p0, 0, pa0); PK4(p0, 8, pa1); PK4(p1, 0, pa2); PK4(p1, 8, pa3);
    const int vbase = (int)(uintptr_t)VI + v_rd_base(lane), kbase = (int)(uintptr_t)KT + v_rd_base(lane);
    bf16x8 v0, v1, v2, v3; vfrags<0>(vbase + vb * 512, v0, v1, v2, v3);
    { f32x16 od;
#pragma unroll
      for (int r = 0; r < 16; ++r) od[r] = 0.f;
      od = MFMA32(pa0, v0, od); od = MFMA32(pa1, v1, od); od = MFMA32(pa2, v2, od); od = MFMA32(pa3, v3, od);
#pragma unroll
      for (int r = 0; r < 16; ++r) OI[(size_t)(row0 + 32 * tb + crow(r, hi)) * 512 + h * 128 + 32 * vb + r32] = od[r]; }
#pragma unroll
    for (int e = 0; e < 2; ++e) { const int kb = 2 * (wid & 1) + e;
        bf16x8 k0, k1, k2, k3; vfrags<0>(kbase + kb * 512, k0, k1, k2, k3);
        f32x16 u;
#pragma unroll
        for (int r = 0; r < 16; ++r) u[r] = 0.f;
        u = MFMA32(v0, k0, u); u = MFMA32(v1, k1, u); u = MFMA32(v2, k2, u); u = MFMA32(v3, k3, u);
#pragma unroll
        for (int r = 0; r < 16; ++r) UT[((size_t)unit * 128 + 32 * vb + crow(r, hi)) * 128 + 32 * kb + r32] = (bf16)(cvtpk(u[r], 0.f) & 0xffffu); }
    __syncthreads();
}
DI void hgrn_h2(Frame& F) {
    bf16* UT = (bf16*)(F.ws + WS_UT); const float* DC = (const float*)(F.ws + WS_DC);
    for (int g = F.vcu * 512 + F.tid; g < 16 * 128 * 64; g += F.G * 512) {
        const int bh = g >> 13, rem = g & 8191, v = rem >> 6, kp = rem & 63;
        unsigned* base = (unsigned*)(UT + ((size_t)bh * 64 * 128 + v) * 128 + 2 * kp);
        const float* dc = DC + (size_t)bh * 64 * 128 + 2 * kp;
        float s0 = 0.f, s1 = 0.f;
        for (int c0 = 0; c0 < 64; c0 += 8) {
            unsigned u[8]; float d0[8], d1[8];
#pragma unroll
            for (int i = 0; i < 8; ++i) { u[i] = base[(size_t)(c0 + i) * 4096 * 2]; d0[i] = dc[(c0 + i) * 128]; d1[i] = dc[(c0 + i) * 128 + 1]; }
#pragma unroll
            for (int i = 0; i < 8; ++i) { base[(size_t)(c0 + i) * 4096 * 2] = pk2(s0, s1); s0 = d0[i] * s0 + bflo(u[i]); s1 = d1[i] * s1 + bfhi(u[i]); }
        }
    }
}
DI void hgrn_h3_unit(Frame& F, int unit, const float* gout) {
    using namespace att;
    const bf16* Z = (const bf16*)(F.ws + WS_Z); const bf16* QD = (const bf16*)(F.ws + WS_QD); const float* OI = (const float*)(F.ws + WS_OI); const bf16* ST = (const bf16*)(F.ws + WS_UT);
    bf16* OC = (bf16*)(F.ws + WS_XN);
    const int bh = unit >> 6, c = unit & 63, b = bh >> 2, h = bh & 3, row0 = b * SEQ + c * 64;
    unsigned char* lds = F.ldsg;
    char* SI = (char*)lds; char* QI = (char*)lds + 32768; float* PART = (float*)(lds + 49152);
    const int tid = F.tid, wid = F.wave, lane = F.lane, r32 = lane & 31, hi = lane >> 5;
#pragma unroll
    for (int i = 0; i < 4; ++i) { const int idx = tid + 512 * i, row = idx >> 4, c8 = idx & 15;
        *(v4u*)(SI + kswz<256>(row, c8 * 16)) = *(const v4u*)(ST + ((size_t)unit * 128 + row) * 128 + c8 * 8); }
#pragma unroll
    for (int i = 0; i < 2; ++i) { const int idx = tid + 512 * i, row = idx >> 4, c8 = idx & 15;
        *(v4u*)(QI + kswz<256>(row, c8 * 16)) = *(const v4u*)(QD + (size_t)(row0 + row) * 512 + h * 128 + c8 * 8); }
    __syncthreads();
    const int tb = wid & 1, vb = wid >> 1;
    f32x16 acc;
#pragma unroll
    for (int r = 0; r < 16; ++r) acc[r] = 0.f;
#pragma unroll
    for (int d0 = 0; d0 < 8; ++d0) { const int cb = (d0 * 16 + hi * 8) * 2;
        const bf16x8 a = *reinterpret_cast<const bf16x8*>(QI + kswz<256>(32 * tb + r32, cb));
        const bf16x8 bb = *reinterpret_cast<const bf16x8*>(SI + kswz<256>(32 * vb + r32, cb));
        acc = MFMA32(a, bb, acc); }
#pragma unroll
    for (int r = 0; r < 16; ++r) { const int trow = row0 + 32 * tb + crow(r, hi);
        acc[r] += OI[(size_t)trow * 512 + h * 128 + 32 * vb + r32];
        float s = acc[r] * acc[r];
        s += __shfl_xor(s, 1); s += __shfl_xor(s, 2); s += __shfl_xor(s, 4); s += __shfl_xor(s, 8); s += __shfl_xor(s, 16);
        if (r32 == 0) PART[(32 * tb + crow(r, hi)) * 4 + vb] = s; }
    __syncthreads();
    const float gv = gout[h * 128 + 32 * vb + r32];
#pragma unroll
    for (int r = 0; r < 16; ++r) { const int t = 32 * tb + crow(r, hi), trow = row0 + t;
        const f32x4 pp = *(const f32x4*)(PART + t * 4);
        const float rs = 1.f / sqrtf(((pp[0] + pp[1]) + (pp[2] + pp[3])) * (1.f / 128.f) + EPS);
        const float gt = bf2f(Z[(size_t)trow * ZE + 2304 + h * 128 + 32 * vb + r32]);
        const float sg = gt * __builtin_amdgcn_rcpf(1.f + fexp(-gt));
        OC[(size_t)trow * 1024 + 512 + h * 128 + 32 * vb + r32] = (bf16)(cvtpk(acc[r] * rs * gv * sg, 0.f) & 0xffffu); }
    __syncthreads();
}
DI void diff_combine(Frame& F, const float* lamp, const float* ghead, float linit) {
    const bf16* OD = (const bf16*)(F.ws + WS_Q); bf16* OC = (bf16*)(F.ws + WS_XN);
    const float sa = wave_sum(lamp[F.lane] * lamp[64 + F.lane]), sb = wave_sum(lamp[128 + F.lane] * lamp[192 + F.lane]);
    const float lam = fexp(sa) - fexp(sb) + linit, post = 1.f - linit;
    const int gw = F.vcu * NWAVES + F.wave, NGW = F.G * NWAVES;
    for (int m = gw; m < M; m += NGW) {
#pragma unroll
        for (int h = 0; h < 8; ++h) {
            const unsigned a = *(const unsigned*)(OD + (size_t)m * 2048 + (2 * h) * 128 + 2 * F.lane), bq = *(const unsigned*)(OD + (size_t)m * 2048 + (2 * h + 1) * 128 + 2 * F.lane);
            const float d0 = bflo(a) - lam * bflo(bq), d1 = bfhi(a) - lam * bfhi(bq);
            const float rs = post / sqrtf(wave_sum(d0 * d0 + d1 * d1) * (1.f / 128.f) + EPS);
            const float g0 = ghead[h * 128 + 2 * F.lane], g1 = ghead[h * 128 + 2 * F.lane + 1];
            *(unsigned*)(OC + (size_t)m * 1024 + h * 128 + 2 * F.lane) = pk2(d0 * rs * g0, d1 * rs * g1);
        }
    }
}

#ifndef PHASE_MASK
#define PHASE_MASK 0xFFFFF
#endif
#define EN(k) ((PHASE_MASK >> (k)) & 1)
#ifndef QKV_REP
#define QKV_REP 1
#endif
#ifndef H1_REP
#define H1_REP 1
#endif
#ifndef PROBE_A
#define PROBE_A -1
#define PROBE_B -1
#define PROBE_N 2
#endif
#ifndef MK_PER_PHASE
#define MK_PER_PHASE 0
#endif
constexpr int N_PHASES = 1 + 4 * 6 + 2 * 6 + 2 * 4;
__global__ void __launch_bounds__(NWAVES * 64, 2) fwd_kernel(Args args) {
    extern __shared__ __attribute__((aligned(16))) unsigned char lds[];
    Frame F;
    F.lds = (LAS unsigned char*)lds; F.ldsg = lds;
    F.MISC = (volatile LAS unsigned*)(F.lds + MISC_OFF);
    F.tid = threadIdx.x; F.lane = F.tid & 63; F.wave = __builtin_amdgcn_readfirstlane(F.tid >> 6);
    F.G = gridDim.x; { const int bx = blockIdx.x; F.vcu = (F.G % 8 == 0) ? (bx % 8) * (F.G / 8) + bx / 8 : bx; }
    KA const Args* A = (KA const Args*)__builtin_amdgcn_kernarg_segment_ptr();
    F.ws = A->ws; F.ctl = (gu32*)(A->ws + WS_CTL);
    for (int u = F.tid; u < (LDS_BYTES - LDSCTL_OFF) / 4; u += NWAVES * 64) ((LAS unsigned*)(F.lds + LDSCTL_OFF))[u] = 0u;
    __syncthreads();
    const int lo = A->ph_lo, hi = A->ph_hi;
    XcdBarrier bar; bar.bar = (unsigned*)(F.ctl + CW_BAR); bar.x = 0; bar.st = nullptr;
    if (hi - lo > 1) bar = xcd_barrier_post((unsigned*)(F.ctl + CW_BAR) + A->li * XCD_BAR_WORDS, F.MISC + 8);
    int ph = 0;
#define PH_ON (ph >= lo && ph < hi)
#define PH_END do { if (ph >= lo && ph + 1 < hi) xcd_barrier(bar); ++ph; } while (0)

#define x_in ((const float*)A->in[0])
#define norm_g ((const float*)A->in[2])
#define X (A->out)
#define XN ((bf16*)(F.ws + WS_XN))
#define Y ((bf16*)(F.ws + WS_Y))
#define Zb ((bf16*)(F.ws + WS_Z))
#define W (F.ws + WS_W)
#define LAUNDER do { KA const Args* ap_ = (KA const Args*)__builtin_amdgcn_kernarg_segment_ptr(); asm volatile("" : "+s"(ap_)); A = ap_; unsigned char* w_ = ap_->ws; asm volatile("" : "+s"(w_)); F.ws = w_; int t_ = threadIdx.x; asm volatile("" : "+v"(t_)); F.tid = t_; F.lane = t_ & 63; F.wave = __builtin_amdgcn_readfirstlane(t_ >> 6); int g_ = gridDim.x, b_ = blockIdx.x; asm volatile("" : "+s"(g_), "+s"(b_)); F.G = g_; F.bx = b_; F.vcu = (g_ % 8 == 0) ? (b_ % 8) * (g_ / 8) + b_ / 8 : b_; } while (0)
    constexpr float LOG2E = 1.4426950408889634f;

    if (PH_ON && EN(0)) { LAUNDER; build_tables(F, A); convert_layer(F, A, 0); thin_rows(F, x_in, nullptr, nullptr, nullptr, 0.f, norm_g, XN); }
    PH_END;

    for (int l = 0; l < DEPTH; ++l) {
        #define g_l (norm_g + (size_t)l * 6 * D)
        for (int half = 0; half < 2; ++half) {
            if (PH_ON && EN(1)) { LAUNDER;
                pg8::Gemm g{XN, (const bf16*)(W + (half ? W_GU1 : W_GU0)), M, 2 * FF, D, D, D}; pg8::StaticOrder S; S.init(M, 2 * FF, F.G, F.bx);
                pg8::EpiSwiglu E{Zb, FF};
                pg8::gemm_phase<pg8::EpiSwiglu, pg8::StaticOrder, true, true>(F.lds + RING_OFF, g, S, E);
            }
            PH_END;
            if (PH_ON && EN(2)) { LAUNDER;
                pg8::Gemm g{Zb, (const bf16*)(W + (half ? W_D1 : W_D0)), M, D, FF, FF, FF}; pg8::StaticOrder S; S.init(M, D, F.G, F.bx);
                pg8::EpiPlain E{Y, D};
                pg8::gemm_phase<pg8::EpiPlain, pg8::StaticOrder, true, true>(F.lds + RING_OFF, g, S, E);
            }
            PH_END;
            if (PH_ON && EN(3)) { LAUNDER;
                const float* xin = (l == 0 && half == 0) ? x_in : X;
                const float* gpost = g_l + (half ? 5 : 1) * D;
                const float* gpre = half == 0 ? g_l + 2 * D : (l + 1 < DEPTH ? norm_g + (size_t)(l + 1) * 6 * D : nullptr);
                thin_rows(F, xin, X, Y, gpost, 0.5f, gpre, XN);
                if (half == 1 && l + 1 < DEPTH) convert_layer(F, A, l + 1);
            }
            PH_END;
            if (half == 0) {
                const int j = l >> 1;
                if ((l & 1) == 0) {
                    if (PH_ON && EN(4)) { LAUNDER;
                        pg8::Gemm g{XN, (const bf16*)(W + W_EIN), M, ZE, D, D, D}; pg8::StaticOrder S; S.init(M, ZE, F.G, F.bx);
                        pg8::EpiZEven E{Zb, (float*)(F.ws + WS_SP), (bf16*)(F.ws + WS_K), (const float*)(F.ws + WS_TM)};
                        pg8::gemm_phase<pg8::EpiZEven, pg8::StaticOrder, true, true>(F.lds + RING_OFF, g, S, E);
                    }
                    PH_END;
                    if (PH_ON && EN(5)) { LAUNDER;
                        LAS float* RS = (LAS float*)(F.lds + RS_OFF); LAS int* RSPM = (LAS int*)(F.lds + RS_OFF + 4096);
                        for (int rq_ = 0; rq_ < QKV_REP; ++rq_) {
                        if (EN(14)) { pg8::Gemm g{Zb, (const bf16*)(W + W_EUQ), M, 768, 384, ZE, 384}; pg8::StaticOrder S; S.init(M, 768, F.G, F.bx);
                          fill_rs(F, S, (const float*)(F.ws + WS_SP), 0, 3, 1.0f / 384.0f, 0.07216878364870322f * LOG2E, RS, RSPM);
                          pg8::EpiQ E{(bf16*)(F.ws + WS_Q), RS, RSPM, (const float*)(F.ws + WS_TM)};
                          pg8::gemm_phase<pg8::EpiQ, pg8::StaticOrder, true, true>(F.lds + RING_OFF, g, S, E); }
                        __syncthreads();
                        LAUNDER;
                        if (EN(15)) { pg8::Gemm g{Zb + 384, (const bf16*)(W + W_EUKV), M, 1024, 256, ZE, 256}; pg8::StaticOrder S; S.init(M, 1024, F.G, F.bx);
                          fill_rs(F, S, (const float*)(F.ws + WS_SP), 12, 2, 1.0f / 256.0f, 1.0f, RS, RSPM);
                          pg8::EpiKV E{(bf16*)(F.ws + WS_K), (bf16*)(F.ws + WS_V), RS, RSPM};
                          pg8::gemm_phase<pg8::EpiKV, pg8::StaticOrder, true, true>(F.lds + RING_OFF, g, S, E); }
                        __syncthreads();
                        }
                        LAUNDER;
                        if (EN(16)) for (int rep_ = 0; rep_ < H1_REP; ++rep_) for (int u = F.vcu; u < 1024; u += F.G) hgrn_h1_unit(F, u, j);
                    }
                    PH_END;
                    if (PH_ON && EN(6)) { LAUNDER;
                        if (EN(17)) hgrn_h2(F);
                        LAUNDER;
                        if (EN(18))
                        for (int u = F.vcu; u < 256; u += F.G) {
                            const int st = u >> 4, qb = 15 - (u & 15), b = st >> 2, h = st & 3;
                            att::attn_unit<192>((const bf16*)(F.ws + WS_Q) + (size_t)b * SEQ * 768 + h * 192, 768, (const bf16*)(F.ws + WS_K) + (size_t)b * SEQ * 768 + h * 192, 768,
                                                (const bf16*)(F.ws + WS_V) + (size_t)b * SEQ * 512 + h * 128, 512, XN + (size_t)b * SEQ * 1024 + h * 128, 1024, qb * 256, (char*)F.ldsg);
                        }
                    }
                    PH_END;
                    if (PH_ON && EN(7)) { LAUNDER; const float* gout = (const float*)A->in[12] + j * 512; for (int u = F.vcu; u < 1024; u += F.G) hgrn_h3_unit(F, u, gout); }
                    PH_END;
                    if (PH_ON && EN(8)) { LAUNDER;
                        pg8::Gemm g{XN, (const bf16*)(W + W_EOUT), M, D, D, D, D}; pg8::StaticOrder S; S.init(M, D, F.G, F.bx);
                        pg8::EpiPlain E{Y, D};
                        pg8::gemm_phase<pg8::EpiPlain, pg8::StaticOrder, true, true>(F.lds + RING_OFF, g, S, E);
                    }
                    PH_END;
                } else {
                    if (PH_ON && EN(9)) { LAUNDER;
                        pg8::Gemm g{XN, (const bf16*)(W + W_OIN), M, ZO, D, D, D}; pg8::StaticOrder S; S.init(M, ZO, F.G, F.bx);
                        pg8::EpiZOdd E{Zb, (const float*)(F.ws + WS_TD), 0.125f * LOG2E};
                        pg8::gemm_phase<pg8::EpiZOdd, pg8::StaticOrder, true, true>(F.lds + RING_OFF, g, S, E);
                    }
                    PH_END;
                    if (PH_ON && EN(10)) { LAUNDER;
                        const float* lamp = (const float*)A->in[15] + j * 256;
                        const float sa = wave_sum(lamp[F.lane] * lamp[64 + F.lane]), sb = wave_sum(lamp[128 + F.lane] * lamp[192 + F.lane]);
                        const float linit = A->linit[j], lam = fexp(sa) - fexp(sb) + linit;
                        for (int c = F.vcu; c < 256; c += F.G) {
                            const int bh = c >> 3, gq = c & 7, b = bh >> 3, h = bh & 7;
#pragma unroll 1
                            for (int k = 0; k < 2; ++k) {
                                const int qb = k == 0 ? 15 - gq : gq;
                                att::attn_diff_unit(Zb + (size_t)b * SEQ * ZO, ZO, h, XN + (size_t)b * SEQ * 1024 + h * 128, 1024, qb * 256, lam, 1.f - linit,
                                                    (const float*)A->in[16] + j * 1024 + h * 128, (char*)F.ldsg, (char*)F.ldsg + RS_OFF);
                            }
                        }
                    }
                    PH_END;
                    if (PH_ON && EN(12)) { LAUNDER;
                        pg8::Gemm g{XN, (const bf16*)(W + W_OOUT), M, D, D, D, D}; pg8::StaticOrder S; S.init(M, D, F.G, F.bx);
                        pg8::EpiPlain E{Y, D};
                        pg8::gemm_phase<pg8::EpiPlain, pg8::StaticOrder, true, true>(F.lds + RING_OFF, g, S, E);
                    }
                    PH_END;
                }
                if (PH_ON && EN(13)) { LAUNDER; thin_rows(F, X, X, Y, g_l + 3 * D, 1.0f, g_l + 4 * D, XN); }
                PH_END;
            }
        }
    }
#undef PH_ON
#undef PH_END
#undef XN
#undef Y
#undef Zb
#undef W
#undef LAUNDER
#undef x_in
#undef norm_g
#undef X
#undef g_l
}

extern "C" void kernel_launch(void* const* d_in, const int* in_sizes, int n_in, void* d_out, int out_size, void* d_ws, size_t ws_size, hipStream_t stream) {
    static int grid = 0;
    if (grid == 0) {
        if (n_in != 18 || in_sizes[0] != M * D || out_size != M * D || ws_size < WS_END) { fprintf(stderr, "kernel_launch: unexpected shapes (n_in %d, in0 %d, out %d, ws %zu)\n", n_in, n_in > 0 ? in_sizes[0] : -1, out_size, ws_size); grid = -1; return; }
        int dev = 0, cus = 0, per_cu = 0;
        if (hipGetDevice(&dev) != hipSuccess || hipDeviceGetAttribute(&cus, hipDeviceAttributeMultiprocessorCount, dev) != hipSuccess) { grid = -1; return; }
        if (hipFuncSetAttribute((const void*)fwd_kernel, hipFuncAttributeMaxDynamicSharedMemorySize, LDS_BYTES) != hipSuccess) { fprintf(stderr, "kernel_launch: hipFuncSetAttribute failed\n"); grid = -1; return; }
        if (hipOccupancyMaxActiveBlocksPerMultiprocessor(&per_cu, (const void*)fwd_kernel, NWAVES * 64, LDS_BYTES) != hipSuccess || per_cu < 1)
            fprintf(stderr, "kernel_launch: note: occupancy query reports %d workgroups per CU\n", per_cu);
        (void)hipGetLastError();
        grid = cus;
    }
    if (grid < 0) return;
    if (hipMemsetAsync((char*)d_ws + WS_CTL, 0, CTL_ZERO_BYTES, stream) != hipSuccess) return;
    Args a{};
    for (int i = 0; i < 18; ++i) a.in[i] = d_in[i];
    a.out = (float*)d_out; a.ws = (unsigned char*)d_ws;
    for (int i = 0; i < 32; ++i) a.invf_m[i] = (float)pow(500000.0, -(double)(2 * i) / 64.0);
    for (int i = 0; i < 8; ++i) a.invf_d[i] = (float)pow(500000.0, -(double)(2 * i) / 16.0);
    for (int jj = 0; jj < 2; ++jj) a.linit[jj] = (float)(0.8 - 0.6 * exp(-0.3 * (double)(2 * jj + 1)));
#if MK_PER_PHASE
    for (int p = 0; p < N_PHASES; ++p) { a.ph_lo = p; a.ph_hi = p + 1; a.li = 0; hipLaunchKernelGGL(fwd_kernel, dim3(grid), dim3(NWAVES * 64), LDS_BYTES, stream, a); }
#else
    if (PROBE_A >= 0) {
        a.ph_lo = 0; a.ph_hi = PROBE_B + 1; a.li = 0; hipLaunchKernelGGL(fwd_kernel, dim3(grid), dim3(NWAVES * 64), LDS_BYTES, stream, a);
        for (int r = 1; r < PROBE_N; ++r) { a.ph_lo = PROBE_A; a.ph_hi = PROBE_B + 1; a.li = r; hipLaunchKernelGGL(fwd_kernel, dim3(grid), dim3(NWAVES * 64), LDS_BYTES, stream, a); }
        a.ph_lo = PROBE_A; a.ph_hi = N_PHASES; a.li = PROBE_N; hipLaunchKernelGGL(fwd_kernel, dim3(grid), dim3(NWAVES * 64), LDS_BYTES, stream, a);
    } else {
        a.ph_lo = 0; a.ph_hi = N_PHASES; a.li = 0;
        hipLaunchKernelGGL(fwd_kernel, dim3(grid), dim3(NWAVES * 64), LDS_BYTES, stream, a);
    }
#endif
    const hipError_t le = hipPeekAtLastError();
    if (le != hipSuccess) fprintf(stderr, "kernel_launch: launch failed: %s\n", hipGetErrorName(le));
}
```
